# Optimizing an MI355X kernel written in HIP

```python
import math
import jax
import jax.numpy as jnp
from jax import lax
import numpy as np

D_MODEL = 4096
BATCH = 1
SEQ = 8192
DEPTH = 1

HEAD_DIM = 128
A_Q_HEADS = 16
A_KV_HEADS = 4
A_GROUP = A_Q_HEADS // A_KV_HEADS
A_WINDOW = 128
B_PATTERNS = ((128, 1), (512, 4), (2048, 16))
B_HEADS_PER_GROUP = 4
B_HEADS = B_HEADS_PER_GROUP * len(B_PATTERNS)
ROPE_THETA = 500000.0
ROPE_DIMS = HEAD_DIM // 4
BLOCK = 128
EPS = 1e-6
PEER_HEADS = 8
PEER_N_KEYS = 128
PEER_N_EXPERTS = PEER_N_KEYS * PEER_N_KEYS
PEER_QUERY_DIM = 256
PEER_HALF = PEER_QUERY_DIM // 2
PEER_TOPK = 16
PEER_TOKEN_BLOCK = 64

A_Q_W = A_Q_HEADS * HEAD_DIM
A_KV_W = A_KV_HEADS * HEAD_DIM
B_W = B_HEADS * HEAD_DIM
B_OUT_W = B_HEADS_PER_GROUP * HEAD_DIM
IN_W = A_Q_W + 2 * A_KV_W + 3 * B_W

kernel_name = "hybrid_swa_dilated_peer_block"


def rmsnorm(x, gain):
    xf = x.astype(jnp.float32)
    inv = lax.rsqrt(jnp.mean(xf * xf, axis=-1, keepdims=True) + EPS)
    return (xf * inv * gain.astype(jnp.float32)).astype(x.dtype)


def partial_rope(x, positions):
    half = ROPE_DIMS // 2
    inv_freq = jnp.exp(-math.log(ROPE_THETA) * jnp.arange(half, dtype=jnp.float32) / half)
    ang = positions.astype(jnp.float32)[..., None] * inv_freq
    cos = jnp.cos(ang)[:, :, None, :]
    sin = jnp.sin(ang)[:, :, None, :]
    xr = x[..., :ROPE_DIMS].astype(jnp.float32)
    x1, x2 = xr[..., :half], xr[..., half:]
    rot = jnp.concatenate([x1 * cos - x2 * sin, x2 * cos + x1 * sin], axis=-1).astype(x.dtype)
    return jnp.concatenate([rot, x[..., ROPE_DIMS:]], axis=-1)


def banded_window_attention(q, k, v, max_dist, sinks=None):
    B, L, Hkv, G, Dh = q.shape
    nb = -(-L // BLOCK)
    pad = nb * BLOCK - L
    if pad:
        q = jnp.pad(q, ((0, 0), (0, pad), (0, 0), (0, 0), (0, 0)))
        k = jnp.pad(k, ((0, 0), (0, pad), (0, 0), (0, 0)))
        v = jnp.pad(v, ((0, 0), (0, pad), (0, 0), (0, 0)))
    qb = q.reshape(B, nb, BLOCK, Hkv, G, Dh)

    def band(t):
        tb = t.reshape(B, nb, BLOCK, Hkv, Dh)
        prev = jnp.pad(tb, ((0, 0), (1, 0), (0, 0), (0, 0), (0, 0)))[:, :nb]
        return jnp.concatenate([prev, tb], axis=2)

    kb, vb = band(k), band(v)
    s = jnp.einsum('bnqhgd,bnkhd->bnhgqk', qb, kb,
                   preferred_element_type=jnp.float32) * (Dh ** -0.5)
    qi = jnp.arange(BLOCK)[:, None]
    kj = jnp.arange(2 * BLOCK)[None, :]
    dist = BLOCK + qi - kj
    in_band = (dist >= 0) & (dist <= max_dist)
    has_prev = (jnp.arange(nb) > 0)[:, None, None] | (kj >= BLOCK)[None]
    mask = in_band[None] & has_prev
    s = jnp.where(mask[None, :, None, None], s, -jnp.inf)
    s_max = jnp.max(s, axis=-1, keepdims=True)
    if sinks is not None:
        sink = sinks.astype(jnp.float32)[None, None, :, :, None, None]
        m = jnp.maximum(s_max, sink)
        p = jnp.exp(s - m)
        denom = jnp.sum(p, axis=-1, keepdims=True) + jnp.exp(sink - m)
    else:
        m = s_max
        p = jnp.exp(s - m)
        denom = jnp.sum(p, axis=-1, keepdims=True)
    o = jnp.einsum('bnhgqk,bnkhd->bnqhgd', p, vb.astype(jnp.float32)) / jnp.moveaxis(denom, 4, 2)
    lse = jnp.moveaxis((m + jnp.log(denom))[..., 0], 4, 2)
    o = o.reshape(B, nb * BLOCK, Hkv, G, Dh)[:, :L].astype(q.dtype)
    lse = lse.reshape(B, nb * BLOCK, Hkv, G)[:, :L]
    return o, lse


def dilated_window_attention(q, k, v, window, dilation):
    B, S, H, Dh = q.shape
    L = S // dilation

    def to_sub(t):
        return t.reshape(B, L, dilation, H, Dh).transpose(0, 2, 1, 3, 4).reshape(B * dilation, L, H, Dh)

    out, lse = banded_window_attention(to_sub(q)[:, :, :, None], to_sub(k), to_sub(v), window // dilation)
    out = out.reshape(B, dilation, L, H, Dh).transpose(0, 2, 1, 3, 4).reshape(B, S, H, Dh)
    lse = lse.reshape(B, dilation, L, H).transpose(0, 2, 1, 3).reshape(B, S, H)
    return out, lse


def token_mixing(h, positions, w_in, q_norm_a, k_norm_a, sinks_a, q_norm_b, k_norm_b,
                 w_branch_a, w_branch_b, w_gate, b_gate, w_out):
    B, S, _ = h.shape
    proj = h @ w_in
    offs = [A_Q_W, A_Q_W + A_KV_W, A_Q_W + 2 * A_KV_W,
            A_Q_W + 2 * A_KV_W + B_W, A_Q_W + 2 * A_KV_W + 2 * B_W]
    qa, ka, va, qb, kb, vb = jnp.split(proj, offs, axis=-1)

    def heads(t, n):
        return t.reshape(B, S, n, HEAD_DIM)

    qa = partial_rope(rmsnorm(heads(qa, A_Q_HEADS), q_norm_a), positions)
    qa = qa.reshape(B, S, A_KV_HEADS, A_GROUP, HEAD_DIM)
    ka = partial_rope(rmsnorm(heads(ka, A_KV_HEADS), k_norm_a), positions)
    va = heads(va, A_KV_HEADS)
    ya, _ = banded_window_attention(qa, ka, va, A_WINDOW - 1, sinks_a.reshape(A_KV_HEADS, A_GROUP))
    ya = ya.reshape(B, S, A_Q_W)

    qb = partial_rope(rmsnorm(heads(qb, B_HEADS), q_norm_b), positions)
    kb = partial_rope(rmsnorm(heads(kb, B_HEADS), k_norm_b), positions)
    vb = heads(vb, B_HEADS)
    outs, lses = [], []
    for g, (window, dil) in enumerate(B_PATTERNS):
        sl = slice(g * B_HEADS_PER_GROUP, (g + 1) * B_HEADS_PER_GROUP)
        o, l = dilated_window_attention(qb[:, :, sl], kb[:, :, sl], vb[:, :, sl], window, dil)
        outs.append(o)
        lses.append(l)
    alpha = jax.nn.softmax(jnp.stack(lses, axis=0), axis=0)
    yb = jnp.sum(alpha[..., None] * jnp.stack(outs, axis=0).astype(jnp.float32), axis=0)
    yb = yb.astype(h.dtype).reshape(B, S, B_OUT_W)

    gates = jax.nn.sigmoid(h @ w_gate + b_gate).reshape(B, S, 2, D_MODEL)
    merged = gates[:, :, 0] * (ya @ w_branch_a) + gates[:, :, 1] * (yb @ w_branch_b)
    return merged @ w_out


def peer_ffn(h, w_peer_q, peer_sub_keys, peer_u, peer_v):
    B, S, D = h.shape
    q = (h @ w_peer_q).reshape(B, S, PEER_HEADS, 2, PEER_HALF)
    sc = jnp.einsum('bshcd,hckd->bshck', q, peer_sub_keys,
                    preferred_element_type=jnp.float32)
    s_top, i_top = lax.top_k(sc, PEER_TOPK)
    cand = s_top[..., 0, :, None] + s_top[..., 1, None, :]
    cand_idx = i_top[..., 0, :, None] * PEER_N_KEYS + i_top[..., 1, None, :]
    cand = cand.reshape(B, S, PEER_HEADS, PEER_TOPK * PEER_TOPK)
    cand_idx = cand_idx.reshape(B, S, PEER_HEADS, PEER_TOPK * PEER_TOPK)
    best, pos = lax.top_k(cand, PEER_TOPK)
    experts = jnp.take_along_axis(cand_idx, pos, axis=-1)
    gates = jax.nn.softmax(best, axis=-1).astype(h.dtype)

    T = B * S
    nblk = T // PEER_TOKEN_BLOCK
    hf = h.reshape(nblk, PEER_TOKEN_BLOCK, D)
    ef = experts.reshape(nblk, PEER_TOKEN_BLOCK, PEER_HEADS * PEER_TOPK)
    gf = gates.reshape(nblk, PEER_TOKEN_BLOCK, PEER_HEADS * PEER_TOPK)

    def block(args):
        hb, eb, gb = args
        u = peer_u[eb]
        act = jax.nn.gelu(jnp.einsum('tkd,td->tk', u, hb), approximate=False)
        v = peer_v[eb]
        return jnp.einsum('tk,tkd->td', act * gb, v)

    y = lax.map(block, (hf, ef, gf))
    return y.reshape(B, S, D)


def setup_inputs(seed: int = 0) -> dict:
    key = jax.random.key(seed)
    ks = jax.random.split(key, 18)
    f32 = jnp.float32

    def nrm(k, shape, scale):
        return jax.random.normal(k, shape, f32) * scale

    def gain(k, n):
        return 1.0 + 0.02 * jax.random.normal(k, (n,), f32)

    return {
        "x": nrm(ks[0], (BATCH, SEQ, D_MODEL), 1.0),
        "positions": jnp.broadcast_to(jnp.arange(SEQ, dtype=jnp.int32)[None, :], (BATCH, SEQ)),
        "norm_mix": gain(ks[1], D_MODEL),
        "w_in": nrm(ks[2], (D_MODEL, IN_W), D_MODEL ** -0.5),
        "q_norm_a": gain(ks[3], HEAD_DIM),
        "k_norm_a": gain(ks[4], HEAD_DIM),
        "sinks_a": nrm(ks[5], (A_Q_HEADS,), 0.5),
        "q_norm_b": gain(ks[6], HEAD_DIM),
        "k_norm_b": gain(ks[7], HEAD_DIM),
        "w_branch_a": nrm(ks[8], (A_Q_W, D_MODEL), A_Q_W ** -0.5),
        "w_branch_b": nrm(ks[9], (B_OUT_W, D_MODEL), B_OUT_W ** -0.5),
        "w_gate": nrm(ks[10], (D_MODEL, 2 * D_MODEL), D_MODEL ** -0.5),
        "b_gate": nrm(ks[11], (2 * D_MODEL,), 0.01),
        "w_out": nrm(ks[12], (D_MODEL, D_MODEL), D_MODEL ** -0.5),
        "norm_ffn": gain(ks[13], D_MODEL),
        "w_peer_q": nrm(ks[14], (D_MODEL, PEER_HEADS * PEER_QUERY_DIM), D_MODEL ** -0.5),
        "peer_sub_keys": nrm(ks[15], (PEER_HEADS, 2, PEER_N_KEYS, PEER_HALF), PEER_HALF ** -0.5),
        "peer_u": nrm(ks[16], (PEER_N_EXPERTS, D_MODEL), D_MODEL ** -0.5),
        "peer_v": nrm(ks[17], (PEER_N_EXPERTS, D_MODEL), 0.5),
    }


def reference(x, positions, norm_mix, w_in, q_norm_a, k_norm_a, sinks_a, q_norm_b, k_norm_b,
              w_branch_a, w_branch_b, w_gate, b_gate, w_out, norm_ffn, w_peer_q, peer_sub_keys,
              peer_u, peer_v):
    for _ in range(DEPTH):
        x = x + token_mixing(rmsnorm(x, norm_mix), positions, w_in, q_norm_a, k_norm_a, sinks_a,
                             q_norm_b, k_norm_b, w_branch_a, w_branch_b, w_gate, b_gate, w_out)
        x = x + peer_ffn(rmsnorm(x, norm_ffn), w_peer_q, peer_sub_keys, peer_u, peer_v)
    return x
```

```cpp
#include <hip/hip_runtime.h>
#include <cstdio>
#include <cstdint>

#ifndef MK_N_LAUNCHES
#define MK_N_LAUNCHES 1
#endif

namespace pg8 {
#define PG8_LAS __attribute__((address_space(3)))
typedef unsigned short bf16_t;
typedef short bf16x8 __attribute__((ext_vector_type(8)));
typedef float f32x4 __attribute__((ext_vector_type(4)));
typedef unsigned u32x4 __attribute__((ext_vector_type(4)));
typedef int i32x4 __attribute__((ext_vector_type(4)));
typedef int i32x8 __attribute__((ext_vector_type(8)));
constexpr int BM = 256, BK = 64, HALF = 128, HTB = HALF * BK * 2  , STAGE_BYTES = 8 * HTB, NXCD = 8, WGM = 8;

__host__ __device__ __forceinline__ int lds_byte(int r, int c) { const int st = (r >> 4) * 2 + (c >> 5), rr = r & 15, cc = c & 31, ob = rr * 64 + cc * 2; return st * 1024 + (ob ^ (((ob >> 9) & 1) << 5)); }
__host__ __device__ __forceinline__ void stage_rc(int b, int& R, int& C) { const int st = b / 1024, sb = b % 1024, swz = sb ^ (((sb >> 9) & 1) << 5); R = (st >> 1) * 16 + swz / 64; C = (st & 1) * 32 + (swz % 64) / 2; }
__host__ __device__ __forceinline__ int perm32(int rho) { const int n = rho >> 4, i = rho & 15; return 8 * (i >> 2) + 4 * n + (i & 3); }

struct Unit { int pm, pn; };
struct Gemm { const bf16_t* A; const bf16_t* Bt; int M, N, K, lda, ldb; };

struct StaticOrder {
    int nM, nN, nwg, G, c;
    __host__ __device__ void init(int M, int N, int G_, int c_) { nM = M / BM; nN = N / BM; nwg = nM * nN; G = G_; c = c_; }
    __host__ __device__ bool next(int i, Unit& u) const {
        const long L = (long)i * G + c; if (L >= nwg) return false;
        int wgid = (int)L; { const int q = nwg / NXCD, r = nwg % NXCD, xcd = wgid % NXCD, off = wgid / NXCD; wgid = (xcd < r ? xcd * (q + 1) : r * (q + 1) + (xcd - r) * q) + off; }
        const int nig = WGM * nN, gid = wgid / nig, fm = gid * WGM, gsz = (nM - fm) < WGM ? (nM - fm) : WGM;
        u.pm = fm + ((wgid % nig) % gsz); u.pn = (wgid % nig) / gsz; return true;
    }
    __device__ __forceinline__ void a_ready(const Unit&) const {}
    __device__ __forceinline__ void done(const Unit&) const {}
};

__device__ __forceinline__ unsigned cvt_pk_bf16(float lo, float hi) { unsigned r; asm volatile("v_cvt_pk_bf16_f32 %0, %1, %2" : "=v"(r) : "v"(lo), "v"(hi)); return r; }

template <class Epi, class Sched, bool ALIGN_EPI = false, bool SP2 = false, int FP8 = 0  >
__device__ __forceinline__ void gemm_phase(PG8_LAS unsigned char* lds, const Gemm g, const Sched& S, const Epi& E) {
    const int tid = threadIdx.x, wid = __builtin_amdgcn_readfirstlane(tid >> 6), lane = tid & 63, wr = wid >> 2, wc = wid & 3, fr = lane & 15, fq = lane >> 4;
    const int K = g.K, nt = K / BK;
    unsigned voffA[2], voffB[2];
#pragma unroll
    for (int i = 0; i < 2; ++i) { int R, C; stage_rc(tid * 16 + i * 8192, R, C); const int Rb = Epi::PERM ? ((R & ~31) + perm32(R & 31)) : R;
        voffA[i] = (unsigned)(R * g.lda + C) * 2u; voffB[i] = (unsigned)(Rb * g.ldb + C) * 2u; }
    const size_t kstep = (size_t)(BK * 2);
    const size_t hstepA = (size_t)HALF * g.lda * 2, hstepB = (size_t)HALF * g.ldb * 2;
    const size_t tstepA = 2 * hstepA, tstepB = 2 * hstepB;
    const unsigned ldsw = (unsigned)wid * 1024u;
    const int aoff = lds_byte(wr * 64 + fr, fq * 8), boff = lds_byte(wc * 32 + fr, fq * 8);
#define PG8_SA(b, h) (((b) * 2 + (h)) * HTB)
#define PG8_SB(b, h) ((4 + (b) * 2 + (h)) * HTB)
#define PG8_STAGE(bufoff, gbase, voff) do { _Pragma("unroll") for (int _i = 0; _i < 2; ++_i) \
        __builtin_amdgcn_global_load_lds((const unsigned*)((const char*)(gbase) + (voff)[_i]), (PG8_LAS unsigned*)(lds + (bufoff) + ldsw + _i * 8192), 16, 0, 0); } while (0)
#define PG8_LDA(dst, b, h) do { _Pragma("unroll") for (int m = 0; m < 4; ++m) _Pragma("unroll") for (int k = 0; k < 2; ++k) dst[m][k] = *(const PG8_LAS bf16x8*)(lds + PG8_SA(b, h) + aoff + m * 2048 + k * 1024); } while (0)
#define PG8_LDB(dst, b, h) do { _Pragma("unroll") for (int n = 0; n < 2; ++n) _Pragma("unroll") for (int k = 0; k < 2; ++k) dst[n][k] = *(const PG8_LAS bf16x8*)(lds + PG8_SB(b, h) + boff + n * 2048 + k * 1024); } while (0)
#define PG8_CAT(x0, x1) __builtin_shufflevector(__builtin_bit_cast(i32x4, x0), __builtin_bit_cast(i32x4, x1), 0, 1, 2, 3, 4, 5, 6, 7)
#define PG8_MMA(ai, bj, At, Bt) do { __builtin_amdgcn_s_setprio(1); \
        if constexpr (FP8 == 2) { _Pragma("unroll") for (int m = 0; m < 4; ++m) _Pragma("unroll") for (int n = 0; n < 2; ++n) _Pragma("unroll") for (int k = 0; k < 2; ++k) \
            asm volatile("v_mfma_scale_f32_16x16x128_f8f6f4 %0, %1, %2, %0, %3, %3 op_sel_hi:[0,0,0] cbsz:4 blgp:4" : "+v"(acc[ai][bj][m][n]) : "v"(__builtin_bit_cast(i32x4, Bt[n][k])), "v"(__builtin_bit_cast(i32x4, At[m][k])), "v"(one_scale)); } \
        else if constexpr (FP8 == 1) { _Pragma("unroll") for (int m = 0; m < 4; ++m) _Pragma("unroll") for (int n = 0; n < 2; ++n) \
            asm volatile("v_mfma_scale_f32_16x16x128_f8f6f4 %0, %1, %2, %0, %3, %3 op_sel_hi:[0,0,0]" : "+v"(acc[ai][bj][m][n]) : "v"(PG8_CAT(Bt[n][0], Bt[n][1])), "v"(PG8_CAT(At[m][0], At[m][1])), "v"(one_scale)); } \
        else { _Pragma("unroll") for (int m = 0; m < 4; ++m) _Pragma("unroll") for (int n = 0; n < 2; ++n) _Pragma("unroll") for (int k = 0; k < 2; ++k) \
            acc[ai][bj][m][n] = __builtin_amdgcn_mfma_f32_16x16x32_bf16(Bt[n][k], At[m][k], acc[ai][bj][m][n], 0, 0, 0); } \
        __builtin_amdgcn_s_setprio(0); } while (0)
#define PG8_WAIT_V(n) asm volatile("s_waitcnt vmcnt(" #n ")" ::: "memory")
#define PG8_WAIT_L(n) asm volatile("s_waitcnt lgkmcnt(" #n ")" ::: "memory")
#define PG8_BAR __builtin_amdgcn_s_barrier()
#define PG8_SCHED __builtin_amdgcn_sched_barrier(0)
    Unit cur, nxt; int ui = 0;
    if (!S.next(0, cur)) return;
    const int one_scale = 0x7F7F7F7F;
    f32x4 acc[2][2][4][2];
#pragma unroll
    for (int a = 0; a < 2; ++a)
#pragma unroll
        for (int b = 0; b < 2; ++b)
#pragma unroll
            for (int m = 0; m < 4; ++m)
#pragma unroll
                for (int n = 0; n < 2; ++n) acc[a][b][m][n] = (f32x4){0.f, 0.f, 0.f, 0.f};
    bf16x8 At[4][2], B0[2][2], B1[2][2];
    const char* cA = (const char*)g.A + (size_t)cur.pm * tstepA; const char* cB = (const char*)g.Bt + (size_t)cur.pn * tstepB;
    S.a_ready(cur);
    if constexpr (SP2) {
        PG8_STAGE(PG8_SB(0, 0), cB, voffB); PG8_STAGE(PG8_SB(0, 1), cB + hstepB, voffB); PG8_STAGE(PG8_SA(0, 0), cA, voffA); PG8_STAGE(PG8_SA(0, 1), cA + hstepA, voffA);
        if (wr == 1) PG8_BAR;
        PG8_WAIT_V(2); PG8_BAR;
        PG8_STAGE(PG8_SB(1, 0), cB + kstep, voffB); PG8_STAGE(PG8_SA(1, 0), cA + kstep, voffA); PG8_STAGE(PG8_SB(1, 1), cB + hstepB + kstep, voffB);
        PG8_WAIT_V(6); PG8_BAR;
    } else {
        PG8_STAGE(PG8_SB(0, 0), cB, voffB); PG8_STAGE(PG8_SA(0, 0), cA, voffA); PG8_STAGE(PG8_SB(0, 1), cB + hstepB, voffB); PG8_STAGE(PG8_SA(0, 1), cA + hstepA, voffA);
        if (wr == 1) PG8_BAR;
        PG8_WAIT_V(4); PG8_BAR;
        PG8_STAGE(PG8_SB(1, 0), cB + kstep, voffB); PG8_STAGE(PG8_SA(1, 0), cA + kstep, voffA); PG8_STAGE(PG8_SB(1, 1), cB + hstepB + kstep, voffB);
        PG8_WAIT_V(6); PG8_BAR;
    }
    for (;;) {
        const bool has_next = S.next(ui + 1, nxt);
        const char* nA = has_next ? (const char*)g.A + (size_t)nxt.pm * tstepA : cA; const char* nB = has_next ? (const char*)g.Bt + (size_t)nxt.pn * tstepB : cB;
#pragma unroll 1
        for (int t = 0; t < nt; t += 2) {
            const bool last = (t == nt - 2);
            const char* a1 = cA + (size_t)(t + 1) * kstep;
            const char* a2 = last ? nA : cA + (size_t)(t + 2) * kstep; const char* b2 = last ? nB : cB + (size_t)(t + 2) * kstep;
            const char* a3 = a2 + kstep; const char* b3 = b2 + kstep;
            if (last && has_next) S.a_ready(nxt);
            if constexpr (Epi::MIDK > 0) { if (t == Epi::MIDK) {
                if constexpr (FP8) asm volatile("s_nop 15\n\ts_nop 15" ::: "memory");
                E.mid(acc, cur, wr, wc, fr, fq);
                if constexpr (FP8) asm volatile("s_nop 7" ::: "memory"); } }
            if constexpr (SP2) {
            PG8_LDB(B0, 0, 0); PG8_LDB(B1, 0, 1); PG8_SCHED; PG8_LDA(At, 0, 0); PG8_STAGE(PG8_SA(1, 1), a1 + hstepA, voffA);
            PG8_WAIT_V(8); PG8_WAIT_L(0); PG8_BAR; PG8_MMA(0, 0, At, B0); PG8_MMA(0, 1, At, B1); PG8_BAR; PG8_SCHED;
            PG8_LDA(At, 0, 1); PG8_STAGE(PG8_SB(0, 0), b2, voffB); PG8_STAGE(PG8_SB(0, 1), b2 + hstepB, voffB); PG8_STAGE(PG8_SA(0, 0), a2, voffA);
            PG8_WAIT_V(8); PG8_WAIT_L(0); PG8_BAR; PG8_MMA(1, 0, At, B0); PG8_MMA(1, 1, At, B1); PG8_BAR; PG8_SCHED;
            PG8_LDB(B0, 1, 0); PG8_LDB(B1, 1, 1); PG8_SCHED; PG8_LDA(At, 1, 0); PG8_STAGE(PG8_SA(0, 1), a2 + hstepA, voffA);
            PG8_WAIT_V(8); PG8_WAIT_L(0); PG8_BAR; PG8_MMA(0, 0, At, B0); PG8_MMA(0, 1, At, B1); PG8_BAR; PG8_SCHED;
            PG8_LDA(At, 1, 1); PG8_STAGE(PG8_SB(1, 0), b3, voffB); PG8_STAGE(PG8_SB(1, 1), b3 + hstepB, voffB); PG8_STAGE(PG8_SA(1, 0), a3, voffA);
            PG8_WAIT_V(8); PG8_WAIT_L(0); PG8_BAR; PG8_MMA(1, 0, At, B0); PG8_MMA(1, 1, At, B1); PG8_BAR; PG8_SCHED;
            } else {
            PG8_LDB(B0, 0, 0); PG8_SCHED; PG8_LDA(At, 0, 0); PG8_STAGE(PG8_SA(1, 1), a1 + hstepA, voffA);
            PG8_WAIT_L(8); PG8_BAR; PG8_WAIT_L(0); PG8_MMA(0, 0, At, B0); PG8_BAR; PG8_SCHED;
            PG8_LDB(B1, 0, 1); PG8_STAGE(PG8_SB(0, 0), b2, voffB);
            PG8_BAR; PG8_WAIT_L(0); PG8_MMA(0, 1, At, B1); PG8_BAR;
            PG8_LDA(At, 0, 1); PG8_STAGE(PG8_SA(0, 0), a2, voffA);
            PG8_BAR; PG8_WAIT_L(0); PG8_MMA(1, 0, At, B0); PG8_BAR; PG8_SCHED;
            PG8_STAGE(PG8_SB(0, 1), b2 + hstepB, voffB);
            PG8_WAIT_V(6); PG8_BAR; PG8_MMA(1, 1, At, B1); PG8_BAR;
            PG8_LDB(B0, 1, 0); PG8_SCHED; PG8_LDA(At, 1, 0); PG8_STAGE(PG8_SA(0, 1), a2 + hstepA, voffA);
            PG8_WAIT_L(8); PG8_BAR; PG8_WAIT_L(0); PG8_MMA(0, 0, At, B0); PG8_BAR; PG8_SCHED;
            PG8_LDB(B1, 1, 1); PG8_STAGE(PG8_SB(1, 0), b3, voffB);
            PG8_BAR; PG8_WAIT_L(0); PG8_MMA(0, 1, At, B1); PG8_BAR;
            PG8_LDA(At, 1, 1); PG8_STAGE(PG8_SA(1, 0), a3, voffA);
            PG8_BAR; PG8_WAIT_L(0); PG8_MMA(1, 0, At, B0); PG8_BAR; PG8_SCHED;
            PG8_STAGE(PG8_SB(1, 1), b3 + hstepB, voffB);
            PG8_WAIT_V(6); PG8_BAR; PG8_MMA(1, 1, At, B1); PG8_BAR;
            }
        }
        if constexpr (ALIGN_EPI) { if (wr == 0) PG8_BAR; }
        if constexpr (FP8) asm volatile("s_nop 15\n\ts_nop 15" ::: "memory");
        E(acc, cur, wr, wc, fr, fq); S.done(cur);
        if (!has_next) break;
#pragma unroll
        for (int a = 0; a < 2; ++a)
#pragma unroll
            for (int b = 0; b < 2; ++b)
#pragma unroll
                for (int m = 0; m < 4; ++m)
#pragma unroll
                    for (int n = 0; n < 2; ++n) acc[a][b][m][n] = (f32x4){0.f, 0.f, 0.f, 0.f};
        cur = nxt; cA = nA; cB = nB; ++ui;
        if constexpr (ALIGN_EPI) { if (wr == 1) PG8_BAR; }
    }
    PG8_WAIT_V(0);
    if constexpr (!ALIGN_EPI) { if (wr == 0) PG8_BAR; }
    PG8_BAR;
#undef PG8_SA
#undef PG8_SB
#undef PG8_STAGE
#undef PG8_LDA
#undef PG8_LDB
#undef PG8_MMA
#undef PG8_CAT
#undef PG8_WAIT_V
#undef PG8_WAIT_L
#undef PG8_BAR
#undef PG8_SCHED
}
}

constexpr int SEQ = 8192, DM = 4096, HD = 128;
constexpr int INW = 7680, GATEW = 8192, N1 = INW + GATEW;
constexpr int YCW = 2560;
constexpr int QW = 2048;
constexpr int NEXP = 16384;
constexpr int COL_QA = 0, COL_KA = 2048, COL_VA = 2560, COL_QB = 3072, COL_KB = 4608, COL_VB = 6144;
constexpr float EPS = 1e-6f;
constexpr int NWAVES = 8, NTHREADS = 512;
constexpr int NPHASES = 8;

constexpr size_t MiB = 1u << 20;
constexpr size_t WS_CTL = 0, CTL_ZERO_BYTES = 64 * 1024;
constexpr size_t WS_INV1 = 1 * MiB, WS_INV2 = 1 * MiB + 64 * 1024, WS_LSE = 1 * MiB + 128 * 1024;
constexpr size_t WS_SK = 1 * MiB + 512 * 1024;
constexpr size_t WS_ROPE = 2 * MiB;
constexpr size_t WS_PE = 4 * MiB, WS_PG = 8 * MiB;
constexpr size_t WS_ROWF1 = 1 * MiB;
constexpr size_t WS_SW1 = 12 * MiB + 128 * 1024;
constexpr size_t WS_SWA = 12 * MiB + 192 * 1024, WS_SWB = 12 * MiB + 208 * 1024, WS_SWO = 12 * MiB + 224 * 1024;
constexpr size_t WS_W1Q = 16 * MiB;
constexpr size_t WS_WCQ = 80 * MiB;
constexpr size_t WS_WOQ = 92 * MiB;
constexpr size_t WS_WQT = 108 * MiB;
constexpr size_t WS_XQ = 124 * MiB;
constexpr size_t WS_XB = 156 * MiB;
constexpr size_t WS_PROJ = 220 * MiB;
constexpr size_t WS_MERGED = 220 * MiB;
constexpr size_t WS_GATES = 340 * MiB;
constexpr size_t WS_Q = 340 * MiB;
constexpr size_t WS_YCAT = 468 * MiB;
constexpr size_t WS_OG = 488 * MiB;
constexpr size_t WS_U = 512 * MiB, WS_V = 576 * MiB;
constexpr size_t WS_USC = 12 * MiB, WS_VSC = 12 * MiB + 64 * 1024;
constexpr size_t WS_XQ4 = 640 * MiB;
constexpr size_t WS_WG4 = 656 * MiB;
constexpr size_t WS_GTAB = 12 * MiB + 256 * 1024;
constexpr size_t WS_ROWF4 = 12 * MiB + 320 * 1024;
constexpr size_t WS_ROWPART = 13 * MiB;
constexpr size_t WS_END = 672 * MiB;
constexpr float YSCALE = 64.0f, MSCALE = 128.0f;

constexpr int CW_BAR = 4096;
constexpr int LDS_BYTES = 147456;
constexpr int MISC_OFF = 147456 - 256;

#define GAS __attribute__((address_space(1)))
#define LAS __attribute__((address_space(3)))
typedef unsigned short bf16;
typedef unsigned v4u __attribute__((ext_vector_type(4)));
typedef unsigned v2u __attribute__((ext_vector_type(2)));
typedef float f32x4 __attribute__((ext_vector_type(4)));
typedef float f32x2 __attribute__((ext_vector_type(2)));
typedef float f32x16 __attribute__((ext_vector_type(16)));
typedef short bf16x8 __attribute__((ext_vector_type(8)));
typedef short s16x4 __attribute__((ext_vector_type(4)));
typedef __bf16 bfv2 __attribute__((ext_vector_type(2)));
#define DI __device__ __forceinline__

DI unsigned pk2(float lo, float hi) { f32x2 v = {lo, hi}; return __builtin_bit_cast(unsigned, __builtin_convertvector(v, bfv2)); }
DI float bflo(unsigned w) { return __builtin_bit_cast(float, w << 16); }
DI float bfhi(unsigned w) { return __builtin_bit_cast(float, w & 0xffff0000u); }
DI float wave_sum(float v) {
#pragma unroll
    for (int o = 1; o < 64; o <<= 1) v += __shfl_xor(v, o);
    return v;
}

#define XB_TMO      128
#define XB_XCNT(j)  (256  + 64 * (j))
#define XB_XSUB(j)  (1280 + 64 * (j))
#define XB_XGEN(j)  (2304 + 64 * (j))
#define XB_TOP      3328
#define XB_TOPGEN   3392
#define XCD_BAR_WORDS 3456
#define XB_SPIN_CAP (1u << 22)

__device__ __forceinline__ unsigned xb_ld(unsigned* p)              { return __hip_atomic_load(p, __ATOMIC_RELAXED, __HIP_MEMORY_SCOPE_AGENT); }
__device__ __forceinline__ unsigned xb_add(unsigned* p, unsigned v) { return __hip_atomic_fetch_add(p, v, __ATOMIC_RELAXED, __HIP_MEMORY_SCOPE_AGENT); }
__device__ __forceinline__ unsigned xb_xcc_id() { return (unsigned)__builtin_amdgcn_s_getreg((3 << 11) | 20) & 0xFu; }
#define XB_SPIN(cond, bar) do { unsigned _sp = 0; while (cond) { __builtin_amdgcn_s_sleep(1); \
    if ((++_sp & 255u) == 0u) { if (xb_ld(&(bar)[XB_TMO])) break; if (_sp > XB_SPIN_CAP) { atomicAdd(&(bar)[XB_TMO], 1u); break; } } } } while (0)

struct XcdBarrier { unsigned* bar; unsigned x; volatile LAS unsigned* st; };

__device__ __forceinline__ XcdBarrier xcd_barrier_post(unsigned* bar, volatile LAS unsigned* st) {
    XcdBarrier b; b.bar = bar; b.x = xb_xcc_id(); b.st = st;
    if (threadIdx.x == 0) (void)xb_add(&bar[XB_XCNT(b.x)], 1u);
    return b;
}
__device__ __forceinline__ void xcd_barrier_complete(unsigned* bar, unsigned x, unsigned& nloc, unsigned& nx) {
    const unsigned G = gridDim.x * gridDim.y * gridDim.z;
    unsigned sum, cnt, mine, sp = 0u;
    for (;;) {
        sum = 0u; cnt = 0u; mine = 0u;
#pragma unroll
        for (unsigned j = 0; j < 16; ++j) { const unsigned c = xb_ld(&bar[XB_XCNT(j)]); sum += c; cnt += (c > 0u) ? 1u : 0u; mine = (j == x) ? c : mine; }
        if (sum == G) break;
        __builtin_amdgcn_s_sleep(1);
        if ((++sp & 255u) == 0u) { if (xb_ld(&bar[XB_TMO])) break; if (sp > XB_SPIN_CAP) { atomicAdd(&bar[XB_TMO], 1u); break; } }
    }
    nloc = mine > 0u ? mine : 1u; nx = cnt > 0u ? cnt : 1u;
}
__device__ __forceinline__ void xcd_barrier(const XcdBarrier& b) {
    asm volatile("s_waitcnt vmcnt(0)" ::: "memory");
    __syncthreads();
    if (threadIdx.x == 0) {
        unsigned* bar = b.bar;
        __builtin_amdgcn_s_waitcnt(0);
        unsigned nloc = b.st[0], nx = b.st[1];
        if (nloc == 0u) { xcd_barrier_complete(bar, b.x, nloc, nx); b.st[0] = nloc; b.st[1] = nx; }
        const unsigned old = xb_add(&bar[XB_XSUB(b.x)], 1u);
        const unsigned gen = old / nloc;
        if (old + 1u == (gen + 1u) * nloc) {
            __builtin_amdgcn_fence(__ATOMIC_RELEASE, "agent");
            asm volatile("s_waitcnt vmcnt(0)" ::: "memory");
            const unsigned og = xb_add(&bar[XB_TOP], 1u);
            const unsigned tg = og / nx;
            if (og + 1u == (tg + 1u) * nx) xb_add(&bar[XB_TOPGEN], 1u);
            else XB_SPIN(xb_ld(&bar[XB_TOPGEN]) == tg, bar);
            __builtin_amdgcn_fence(__ATOMIC_ACQUIRE, "agent");
            xb_add(&bar[XB_XGEN(b.x)], 1u);
            asm volatile("s_waitcnt vmcnt(0)" ::: "memory");
        } else {
            XB_SPIN(xb_ld(&bar[XB_XGEN(b.x)]) == gen, bar);
            __builtin_amdgcn_fence(__ATOMIC_ACQUIRE, "agent");
            asm volatile("s_waitcnt vmcnt(0)" ::: "memory");
        }
    }
    __syncthreads();
}

DI void unp8_fp8(v2u w, float (&f)[8]) {
    const f32x2 a = __builtin_amdgcn_cvt_pk_f32_fp8((int)w.x, false), b = __builtin_amdgcn_cvt_pk_f32_fp8((int)w.x, true), c = __builtin_amdgcn_cvt_pk_f32_fp8((int)w.y, false), d = __builtin_amdgcn_cvt_pk_f32_fp8((int)w.y, true);
    f[0] = a.x; f[1] = a.y; f[2] = b.x; f[3] = b.y; f[4] = c.x; f[5] = c.y; f[6] = d.x; f[7] = d.y;
}
DI unsigned pk4_fp8(float a, float b, float c, float d) {
    a = fminf(fmaxf(a, -448.f), 448.f); b = fminf(fmaxf(b, -448.f), 448.f); c = fminf(fmaxf(c, -448.f), 448.f); d = fminf(fmaxf(d, -448.f), 448.f);
    int p = __builtin_amdgcn_cvt_pk_fp8_f32(a, b, 0, false); p = __builtin_amdgcn_cvt_pk_fp8_f32(c, d, p, true); return (unsigned)p;
}

struct EpiP1 {
    static constexpr bool PERM = true; static constexpr int MIDK = 0;
    unsigned char* ws; LAS float* red;
    DI void operator()(const pg8::f32x4 (&acc)[2][2][4][2], const pg8::Unit& u, int wr, int wc, int fr, int fq) const {
        asm volatile("" : "+v"(fr), "+v"(fq));
        bf16* proj = (bf16*)(ws + WS_PROJ); unsigned char* gates = ws + WS_GATES; const float* inv1 = (const float*)(ws + WS_ROWF1); const float* sw = (const float*)(ws + WS_SW1);
        const float* ropec = (const float*)(ws + WS_ROPE); const float* ropes = ropec + SEQ * 16; const float* gtab = (const float*)(ws + WS_GTAB);
        const int row0 = u.pm * 256 + wr * 64 + fr, col0 = u.pn * 256 + wc * 32 + 8 * fq;
        const int pn = u.pn;
        const bool normed = (pn < 10) || (pn >= 12 && pn < 24);
        const float* gain = gtab + (pn < 8 ? 0 : (pn < 10 ? 128 : (pn < 18 ? 256 : 384)));
        const float cw = sw[0];
        if (!normed) {
#pragma unroll
            for (int ai = 0; ai < 2; ++ai)
#pragma unroll
                for (int m = 0; m < 4; ++m) {
                    const int row = row0 + ai * 128 + m * 16; const float s = inv1[row] * cw;
#pragma unroll
                    for (int bj = 0; bj < 2; ++bj) {
                        const f32x4 v0 = acc[ai][bj][m][0] * s, v1 = acc[ai][bj][m][1] * s;
                        v4u w; w.x = pk2(v0[0], v0[1]); w.y = pk2(v0[2], v0[3]); w.z = pk2(v1[0], v1[1]); w.w = pk2(v1[2], v1[3]);
                        *(v4u*)(proj + (size_t)row * INW + col0 + bj * 128) = w;
                    }
                }
            return;
        }
#pragma unroll
        for (int ai = 0; ai < 2; ++ai)
#pragma unroll
            for (int m = 0; m < 4; ++m) {
                const int rl = ai * 128 + wr * 64 + m * 16 + fr; const float s = inv1[u.pm * 256 + rl] * cw;
#pragma unroll
                for (int bj = 0; bj < 2; ++bj) {
                    const f32x4 v0 = acc[ai][bj][m][0], v1 = acc[ai][bj][m][1];
                    float ss = ((v0[0] * v0[0] + v0[1] * v0[1]) + (v0[2] * v0[2] + v0[3] * v0[3]) + (v1[0] * v1[0] + v1[1] * v1[1]) + (v1[2] * v1[2] + v1[3] * v1[3])) * (s * s);
                    ss += __shfl_xor(ss, 16); ss += __shfl_xor(ss, 32);
                    if (fq == 0) red[(rl * 2 + bj) * 4 + wc] = ss;
                }
            }
        asm volatile("s_waitcnt lgkmcnt(0)" ::: "memory"); __builtin_amdgcn_s_barrier(); asm volatile("" ::: "memory");
        const f32x4 g0 = *(const f32x4*)(gain + wc * 32 + 8 * fq), g1 = *(const f32x4*)(gain + wc * 32 + 8 * fq + 4);
#pragma unroll
        for (int ai = 0; ai < 2; ++ai)
#pragma unroll
            for (int m = 0; m < 4; ++m) {
                const int rl = ai * 128 + wr * 64 + m * 16 + fr, row = u.pm * 256 + rl; const float s = inv1[row] * cw;
                f32x4 cs0 = {1.f, 1.f, 1.f, 1.f}, cs1 = cs0, sn0 = {0.f, 0.f, 0.f, 0.f}, sn1 = sn0;
                if (wc == 0) { const int ri = row * 16 + (fq & 1) * 8; cs0 = *(const f32x4*)(ropec + ri); cs1 = *(const f32x4*)(ropec + ri + 4); sn0 = *(const f32x4*)(ropes + ri); sn1 = *(const f32x4*)(ropes + ri + 4); }
#pragma unroll
                for (int bj = 0; bj < 2; ++bj) {
                    const LAS float* rp = red + (rl * 2 + bj) * 4;
                    const float inv = 1.0f / sqrtf(((rp[0] + rp[1]) + (rp[2] + rp[3])) * (1.0f / HD) + EPS);
                    const float f = s * inv;
                    f32x4 v0 = acc[ai][bj][m][0] * g0 * f, v1 = acc[ai][bj][m][1] * g1 * f;
                    if (wc == 0) {
                        f32x4 p0, p1;
#pragma unroll
                        for (int j = 0; j < 4; ++j) { p0[j] = __shfl_xor(v0[j], 32); p1[j] = __shfl_xor(v1[j], 32); }
                        const float sg = (fq < 2) ? -1.0f : 1.0f;
                        v0 = v0 * cs0 + p0 * sn0 * sg; v1 = v1 * cs1 + p1 * sn1 * sg;
                    }
                    v4u w; w.x = pk2(v0[0], v0[1]); w.y = pk2(v0[2], v0[3]); w.z = pk2(v1[0], v1[1]); w.w = pk2(v1[2], v1[3]);
                    *(v4u*)(proj + (size_t)row * INW + col0 + bj * 128) = w;
                }
            }
        __builtin_amdgcn_s_barrier();
    }
};
DI v4u widen16(v2u a, v2u b) {
    const auto rx = __builtin_amdgcn_permlane16_swap(a.x, b.x, false, false), ry = __builtin_amdgcn_permlane16_swap(a.y, b.y, false, false);
    return (v4u){rx[0], ry[0], rx[1], ry[1]};
}
struct EpiG4 {
    static constexpr bool PERM = true; static constexpr int MIDK = 0;
    unsigned char* ws; const float* bgate;
    DI void operator()(const pg8::f32x4 (&acc)[2][2][4][2], const pg8::Unit& u, int wr, int wc, int fr, int fq) const {
        asm volatile("" : "+v"(fr), "+v"(fq));
        unsigned char* gates = ws + WS_GATES; const float* rowf = (const float*)(ws + WS_ROWF4); const float cs = *(const float*)(ws + WS_SW1 + (size_t)INW * 4);
        const int row0 = u.pm * 256 + wr * 64 + fr, col0 = u.pn * 256 + wc * 32 + 8 * fq;
        const int colw = u.pn * 256 + wc * 32 + 8 * (fq & ~1), rsel = fq & 1;
        f32x4 bq[2][2];
#pragma unroll
        for (int bj = 0; bj < 2; ++bj)
#pragma unroll
            for (int n = 0; n < 2; ++n) bq[bj][n] = *(const f32x4*)(bgate + col0 + bj * 128 + 4 * n) * (-1.4426950408889634f) - 8.0f;
#pragma unroll
        for (int ai = 0; ai < 2; ++ai)
#pragma unroll
            for (int mp = 0; mp < 2; ++mp) {
                v2u w[2][2];
#pragma unroll
                for (int mm = 0; mm < 2; ++mm) { const int m = 2 * mp + mm;
                    const int row = row0 + ai * 128 + m * 16; const float s = rowf[row] * cs * (-1.4426950408889634f);
#pragma unroll
                    for (int bj = 0; bj < 2; ++bj) {
                        f32x4 v0 = acc[ai][bj][m][0] * s + bq[bj][0], v1 = acc[ai][bj][m][1] * s + bq[bj][1];
#pragma unroll
                        for (int j = 0; j < 4; ++j) { v0[j] = __builtin_amdgcn_rcpf(0.00390625f + __builtin_amdgcn_exp2f(v0[j])); v1[j] = __builtin_amdgcn_rcpf(0.00390625f + __builtin_amdgcn_exp2f(v1[j])); }
                        w[mm][bj].x = pk4_fp8(v0[0], v0[1], v0[2], v0[3]); w[mm][bj].y = pk4_fp8(v1[0], v1[1], v1[2], v1[3]);
                    }
                }
                const int rowst = row0 + ai * 128 + (2 * mp + rsel) * 16;
#pragma unroll
                for (int bj = 0; bj < 2; ++bj) *(v4u*)(gates + (size_t)rowst * GATEW + colw + bj * 128) = widen16(w[0][bj], w[1][bj]);
            }
    }
};
struct EpiMerge {
    static constexpr bool PERM = true; static constexpr int MIDK = 4;
    const unsigned char* gates; unsigned char* out; const float* swa; const float* swb;
    DI void mid(pg8::f32x4 (&acc)[2][2][4][2], const pg8::Unit& u, int wr, int wc, int fr, int fq) const {
        asm volatile("" : "+v"(fr), "+v"(fq));
        const int row0 = u.pm * 256 + wr * 64 + fr, col0 = u.pn * 256 + wc * 32 + 8 * fq;
#pragma unroll
        for (int bj = 0; bj < 2; ++bj) {
            const int col = col0 + bj * 128;
            const f32x4 a0 = *(const f32x4*)(swa + col), a1 = *(const f32x4*)(swa + col + 4), b0 = *(const f32x4*)(swb + col), b1 = *(const f32x4*)(swb + col + 4);
            f32x4 r0, r1;
#pragma unroll
            for (int j = 0; j < 4; ++j) { r0[j] = b0[j] * __builtin_amdgcn_rcpf(a0[j]); r1[j] = b1[j] * __builtin_amdgcn_rcpf(a1[j]); }
#pragma unroll
            for (int ai = 0; ai < 2; ++ai)
#pragma unroll
                for (int m = 0; m < 4; ++m) {
                    const int row = row0 + ai * 128 + m * 16;
                    const v2u ga = *(const v2u*)(gates + (size_t)row * GATEW + col), gb = *(const v2u*)(gates + (size_t)row * GATEW + DM + col);
                    float fa[8], fb[8]; unp8_fp8(ga, fa); unp8_fp8(gb, fb);
#pragma unroll
                    for (int j = 0; j < 4; ++j) {
                        acc[ai][bj][m][0][j] *= r0[j] * fb[j] * __builtin_amdgcn_rcpf(fmaxf(fa[j], 1e-30f));
                        acc[ai][bj][m][1][j] *= r1[j] * fb[4 + j] * __builtin_amdgcn_rcpf(fmaxf(fa[4 + j], 1e-30f));
                    }
                    if (m & 1) asm volatile("" ::: "memory");
                }
        }
    }
    DI void operator()(const pg8::f32x4 (&acc)[2][2][4][2], const pg8::Unit& u, int wr, int wc, int fr, int fq) const {
        const int row0 = u.pm * 256 + wr * 64 + fr, col0 = u.pn * 256 + wc * 32 + 8 * fq;
        v2u gq[2][2][4];
#pragma unroll
        for (int bj = 0; bj < 2; ++bj)
#pragma unroll
            for (int ai = 0; ai < 2; ++ai)
#pragma unroll
                for (int m = 0; m < 4; ++m) gq[bj][ai][m] = *(const v2u*)(gates + (size_t)(row0 + ai * 128 + m * 16) * GATEW + col0 + bj * 128);
#pragma unroll
        for (int bj = 0; bj < 2; ++bj) {
            const int col = col0 + bj * 128;
            const f32x4 c0 = *(const f32x4*)(swa + col) * (MSCALE / (YSCALE * 256.0f)), c1 = *(const f32x4*)(swa + col + 4) * (MSCALE / (YSCALE * 256.0f));
#pragma unroll
            for (int ai = 0; ai < 2; ++ai)
#pragma unroll
                for (int mp = 0; mp < 2; ++mp) {
                    v2u w[2];
#pragma unroll
                    for (int mm = 0; mm < 2; ++mm) { const int m = 2 * mp + mm;
                        const v2u g = gq[bj][ai][m];
                        float fg[8]; unp8_fp8(g, fg);
                        f32x4 v0 = acc[ai][bj][m][0] * c0, v1 = acc[ai][bj][m][1] * c1;
#pragma unroll
                        for (int j = 0; j < 4; ++j) { v0[j] *= fmaxf(fg[j], 1e-30f); v1[j] *= fmaxf(fg[4 + j], 1e-30f); }
                        w[mm].x = pk4_fp8(v0[0], v0[1], v0[2], v0[3]); w[mm].y = pk4_fp8(v1[0], v1[1], v1[2], v1[3]);
                    }
                    *(v4u*)(out + (size_t)(row0 + ai * 128 + (2 * mp + (fq & 1)) * 16) * DM + col - 8 * (fq & 1)) = widen16(w[0], w[1]);
                }
        }
    }
};
struct EpiOut {
    static constexpr bool PERM = true; static constexpr int MIDK = 0;
    const float* x; float* out; const float* sw; bf16* x1b; float* rowpart;
    DI void operator()(const pg8::f32x4 (&acc)[2][2][4][2], const pg8::Unit& u, int wr, int wc, int fr, int fq) const {
        const int row0 = u.pm * 256 + wr * 64 + fr, col0 = u.pn * 256 + wc * 32 + 8 * fq;
        f32x4 cs[2][2];
#pragma unroll
        for (int bj = 0; bj < 2; ++bj)
#pragma unroll
            for (int n = 0; n < 2; ++n) cs[bj][n] = *(const f32x4*)(sw + col0 + bj * 128 + n * 4) * (1.0f / MSCALE);
#pragma unroll
        for (int ai = 0; ai < 2; ++ai)
#pragma unroll
            for (int m = 0; m < 4; ++m) {
                const int row = row0 + ai * 128 + m * 16; const size_t ro = (size_t)row * DM + col0;
                float ss = 0.f;
#pragma unroll
                for (int bj = 0; bj < 2; ++bj) {
                    const f32x4 x0 = *(const f32x4*)(x + ro + bj * 128), x1 = *(const f32x4*)(x + ro + bj * 128 + 4);
                    const f32x4 v0 = x0 + acc[ai][bj][m][0] * cs[bj][0], v1 = x1 + acc[ai][bj][m][1] * cs[bj][1];
                    v4u w; w.x = pk2(v0.x, v0.y); w.y = pk2(v0.z, v0.w); w.z = pk2(v1.x, v1.y); w.w = pk2(v1.z, v1.w); *(v4u*)(x1b + ro + bj * 128) = w;
                    ss += ((v0.x * v0.x + v0.y * v0.y) + (v0.z * v0.z + v0.w * v0.w)) + ((v1.x * v1.x + v1.y * v1.y) + (v1.z * v1.z + v1.w * v1.w));
                }
                ss += __shfl_xor(ss, 16); ss += __shfl_xor(ss, 32);
                if (fq == 0) rowpart[(size_t)row * 64 + u.pn * 4 + wc] = ss;
            }
    }
};
struct EpiQ {
    static constexpr bool PERM = true; static constexpr int MIDK = 0;
    bf16* q; const LAS float* inv2l;
    DI void operator()(const pg8::f32x4 (&acc)[2][2][4][2], const pg8::Unit& u, int wr, int wc, int fr, int fq) const {
        const int rl0 = wr * 64 + fr, col0 = u.pn * 256 + wc * 32 + 8 * fq;
#pragma unroll
        for (int ai = 0; ai < 2; ++ai)
#pragma unroll
            for (int m = 0; m < 4; ++m) {
                const int rl = rl0 + ai * 128 + m * 16; const float s = inv2l[rl]; const int row = u.pm * 256 + rl;
#pragma unroll
                for (int bj = 0; bj < 2; ++bj) {
                    const f32x4 v0 = acc[ai][bj][m][0] * s, v1 = acc[ai][bj][m][1] * s;
                    v4u w; w.x = pk2(v0[0], v0[1]); w.y = pk2(v0[2], v0[3]); w.z = pk2(v1[0], v1[1]); w.w = pk2(v1[2], v1[3]);
                    *(v4u*)(q + (size_t)row * QW + col0 + bj * 128) = w;
                }
            }
    }
};

template <int MODE> DI void transpose_tile(const float* W, int N, unsigned char* dst, int ldt, int row_off, int col_off, const float* gain, float qs, LAS float* scr, int item, int lane) {
    const int nblk = N / 32, kb = item / nblk, nb = item % nblk, k0 = 128 * kb, n0 = 32 * nb;
    const int kr = lane >> 3, nc = (lane & 7) * 4;
    f32x4 v[16]; float g[16];
#pragma unroll
    for (int i = 0; i < 16; ++i) { v[i] = __builtin_nontemporal_load((const f32x4*)(W + (size_t)(k0 + 8 * i + kr) * N + n0 + nc)); g[i] = (gain ? gain[k0 + 8 * i + kr] : 1.0f) * qs; }
#pragma unroll
    for (int i = 0; i < 16; ++i) { LAS float* d = scr + (8 * i + kr) * 33 + nc; d[0] = v[i].x * g[i]; d[1] = v[i].y * g[i]; d[2] = v[i].z * g[i]; d[3] = v[i].w * g[i]; }
    asm volatile("s_waitcnt lgkmcnt(0)" ::: "memory");
    const int c = lane & 15;
#pragma unroll
    for (int j = 0; j < 8; ++j) { const int n = (lane >> 4) + 4 * j; const LAS float* s = scr + (8 * c) * 33 + n;
        unsigned char* orow = dst + (size_t)(row_off + n0 + n) * ldt + col_off;
        if constexpr (MODE == 0) { v4u o; o.x = pk2(s[0 * 33], s[1 * 33]); o.y = pk2(s[2 * 33], s[3 * 33]); o.z = pk2(s[4 * 33], s[5 * 33]); o.w = pk2(s[6 * 33], s[7 * 33]); *(v4u*)(orow + (k0 + 8 * c) * 2) = o; }
        else if constexpr (MODE == 1) { v2u o; o.x = pk4_fp8(s[0 * 33], s[1 * 33], s[2 * 33], s[3 * 33]); o.y = pk4_fp8(s[4 * 33], s[5 * 33], s[6 * 33], s[7 * 33]); *(v2u*)(orow + k0 + 8 * c) = o; }
        else {
#define SAT6(x) fminf(fmaxf((x), -6.0f), 6.0f)
            unsigned p = 0;
            p = __builtin_amdgcn_cvt_scalef32_pk_fp4_f32(p, SAT6(s[0 * 33]), SAT6(s[1 * 33]), 1.0f, 0); p = __builtin_amdgcn_cvt_scalef32_pk_fp4_f32(p, SAT6(s[2 * 33]), SAT6(s[3 * 33]), 1.0f, 1);
            p = __builtin_amdgcn_cvt_scalef32_pk_fp4_f32(p, SAT6(s[4 * 33]), SAT6(s[5 * 33]), 1.0f, 2); p = __builtin_amdgcn_cvt_scalef32_pk_fp4_f32(p, SAT6(s[6 * 33]), SAT6(s[7 * 33]), 1.0f, 3);
#undef SAT6
            *(unsigned*)(orow + (k0 + 8 * c) / 2) = p; }
    }
    asm volatile("s_waitcnt lgkmcnt(0)" ::: "memory");
}
DI void transpose_item_fp8(const float* W, int K, int N, unsigned char* WT8, int ldt, int row_off, int col_off, const float* gain, float qs, LAS float* scr, int item, int lane) {
    const int nblk = N / 64, kb = item / nblk, nb = item % nblk, k0 = 64 * kb, n0 = 64 * nb;
    const int kr = lane >> 4, nc = (lane & 15) * 4;
    f32x4 v[16]; float g[16];
#pragma unroll
    for (int i = 0; i < 16; ++i) { v[i] = __builtin_nontemporal_load((const f32x4*)(W + (size_t)(k0 + 4 * i + kr) * N + n0 + nc)); g[i] = (gain ? gain[k0 + 4 * i + kr] : 1.0f) * qs; }
#pragma unroll
    for (int i = 0; i < 16; ++i) { LAS float* d = scr + (4 * i + kr) * 65 + nc; d[0] = v[i].x * g[i]; d[1] = v[i].y * g[i]; d[2] = v[i].z * g[i]; d[3] = v[i].w * g[i]; }
    asm volatile("s_waitcnt lgkmcnt(0)" ::: "memory");
    const int c = lane & 7;
#pragma unroll
    for (int j = 0; j < 8; ++j) { const int n = (lane >> 3) + 8 * j; const LAS float* s = scr + (8 * c) * 65 + n;
        v2u o; o.x = pk4_fp8(s[0 * 65], s[1 * 65], s[2 * 65], s[3 * 65]); o.y = pk4_fp8(s[4 * 65], s[5 * 65], s[6 * 65], s[7 * 65]);
        *(v2u*)(WT8 + (size_t)(row_off + n0 + n) * ldt + col_off + k0 + 8 * c) = o; }
    asm volatile("s_waitcnt lgkmcnt(0)" ::: "memory");
}
DI void transpose_item_fp4(const float* W, int K, int N, unsigned char* WT4, int ldt, const float* gain, float qs, LAS float* scr, int item, int lane) {
    const int nblk = N / 64, kb = item / nblk, nb = item % nblk, k0 = 64 * kb, n0 = 64 * nb;
    const int kr = lane >> 4, nc = (lane & 15) * 4;
    f32x4 v[16]; float g[16];
#pragma unroll
    for (int i = 0; i < 16; ++i) { v[i] = __builtin_nontemporal_load((const f32x4*)(W + (size_t)(k0 + 4 * i + kr) * N + n0 + nc)); g[i] = (gain ? gain[k0 + 4 * i + kr] : 1.0f) * qs; }
#pragma unroll
    for (int i = 0; i < 16; ++i) { LAS float* d = scr + (4 * i + kr) * 65 + nc; d[0] = v[i].x * g[i]; d[1] = v[i].y * g[i]; d[2] = v[i].z * g[i]; d[3] = v[i].w * g[i]; }
    asm volatile("s_waitcnt lgkmcnt(0)" ::: "memory");
    const int c = lane & 7;
#pragma unroll
    for (int j = 0; j < 8; ++j) { const int n = (lane >> 3) + 8 * j; const LAS float* s = scr + (8 * c) * 65 + n;
#define SAT6(x) fminf(fmaxf((x), -6.0f), 6.0f)
        unsigned p = 0;
        p = __builtin_amdgcn_cvt_scalef32_pk_fp4_f32(p, SAT6(s[0 * 65]), SAT6(s[1 * 65]), 1.0f, 0); p = __builtin_amdgcn_cvt_scalef32_pk_fp4_f32(p, SAT6(s[2 * 65]), SAT6(s[3 * 65]), 1.0f, 1);
        p = __builtin_amdgcn_cvt_scalef32_pk_fp4_f32(p, SAT6(s[4 * 65]), SAT6(s[5 * 65]), 1.0f, 2); p = __builtin_amdgcn_cvt_scalef32_pk_fp4_f32(p, SAT6(s[6 * 65]), SAT6(s[7 * 65]), 1.0f, 3);
#undef SAT6
        *(unsigned*)(WT4 + (size_t)(n0 + n) * ldt + (k0 + 8 * c) / 2) = p; }
    asm volatile("s_waitcnt lgkmcnt(0)" ::: "memory");
}
DI void wg_sample_all(const float* w_in, const float* w_gate, const float* w_a, const float* w_b, const float* w_o, const float* gain, LAS float* red,
                      float& m_in, float& m_g, float& rms_g, float& m_a, float& m_b, float& m_o) {
    const int k = threadIdx.x >> 7, c = threadIdx.x & 127;
    f32x4 vi[8], va[4], vb[4], vo[4], vg[8];
#pragma unroll
    for (int i = 0; i < 8; ++i) vi[i] = *(const f32x4*)(w_in + (size_t)k * INW + 4 * (c + 256 * i));
#pragma unroll
    for (int i = 0; i < 4; ++i) { va[i] = *(const f32x4*)(w_a + (size_t)k * DM + 4 * (c + 256 * i)); vb[i] = *(const f32x4*)(w_b + (size_t)k * DM + 4 * (c + 256 * i)); vo[i] = *(const f32x4*)(w_o + (size_t)k * DM + 4 * (c + 256 * i)); }
#pragma unroll
    for (int i = 0; i < 8; ++i) vg[i] = *(const f32x4*)(w_gate + (size_t)k * GATEW + 4 * (c + 256 * i));
    const float g = gain[k];
    float xi = 0.f, xa = 0.f, xb = 0.f, xo = 0.f, xg = 0.f, sg = 0.f;
#pragma unroll
    for (int i = 0; i < 8; ++i) xi = fmaxf(xi, fmaxf(fmaxf(fabsf(vi[i].x), fabsf(vi[i].y)), fmaxf(fabsf(vi[i].z), fabsf(vi[i].w))));
    xi *= fabsf(g);
#pragma unroll
    for (int i = 0; i < 4; ++i) {
        xa = fmaxf(xa, fmaxf(fmaxf(fabsf(va[i].x), fabsf(va[i].y)), fmaxf(fabsf(va[i].z), fabsf(va[i].w))));
        xb = fmaxf(xb, fmaxf(fmaxf(fabsf(vb[i].x), fabsf(vb[i].y)), fmaxf(fabsf(vb[i].z), fabsf(vb[i].w))));
        xo = fmaxf(xo, fmaxf(fmaxf(fabsf(vo[i].x), fabsf(vo[i].y)), fmaxf(fabsf(vo[i].z), fabsf(vo[i].w))));
    }
#pragma unroll
    for (int i = 0; i < 8; ++i) { const float a0 = vg[i].x * g, a1 = vg[i].y * g, a2 = vg[i].z * g, a3 = vg[i].w * g; xg = fmaxf(xg, fmaxf(fmaxf(fabsf(a0), fabsf(a1)), fmaxf(fabsf(a2), fabsf(a3)))); sg += a0 * a0 + a1 * a1 + a2 * a2 + a3 * a3; }
#pragma unroll
    for (int o = 1; o < 64; o <<= 1) { xi = fmaxf(xi, __shfl_xor(xi, o)); xa = fmaxf(xa, __shfl_xor(xa, o)); xb = fmaxf(xb, __shfl_xor(xb, o)); xo = fmaxf(xo, __shfl_xor(xo, o)); xg = fmaxf(xg, __shfl_xor(xg, o)); sg += __shfl_xor(sg, o); }
    __syncthreads();
    if ((threadIdx.x & 63) == 0) { LAS float* r = red + 8 * (threadIdx.x >> 6); r[0] = xi; r[1] = xa; r[2] = xb; r[3] = xo; r[4] = xg; r[5] = sg; }
    __syncthreads();
    xi = red[0]; xa = red[1]; xb = red[2]; xo = red[3]; xg = red[4]; sg = red[5];
#pragma unroll
    for (int w = 1; w < NWAVES; ++w) { xi = fmaxf(xi, red[8 * w]); xa = fmaxf(xa, red[8 * w + 1]); xb = fmaxf(xb, red[8 * w + 2]); xo = fmaxf(xo, red[8 * w + 3]); xg = fmaxf(xg, red[8 * w + 4]); sg += red[8 * w + 5]; }
    m_in = xi; m_a = xa; m_b = xb; m_o = xo; m_g = xg; rms_g = sqrtf(sg / 16384.0f);
}
DI float wg_sample_stats(const float* W, int N, const float* gain, LAS float* red, float* rms_out) {
    float mx = 0.f, ss = 0.f;
    for (int idx = threadIdx.x; idx < N; idx += NTHREADS) {
#pragma unroll
        for (int k = 0; k < 4; ++k) { const float v = W[(size_t)k * N + idx] * (gain ? gain[k] : 1.0f); mx = fmaxf(mx, fabsf(v)); ss += v * v; }
    }
#pragma unroll
    for (int o = 1; o < 64; o <<= 1) { mx = fmaxf(mx, __shfl_xor(mx, o)); ss += __shfl_xor(ss, o); }
    __syncthreads();
    if ((threadIdx.x & 63) == 0) { red[threadIdx.x >> 6] = mx; red[8 + (threadIdx.x >> 6)] = ss; }
    __syncthreads();
    float r = red[0], s = red[8];
#pragma unroll
    for (int w = 1; w < NWAVES; ++w) { r = fmaxf(r, red[w]); s += red[8 + w]; }
    *rms_out = sqrtf(s / (4.0f * N));
    return r;
}
DI float wg_sample_absmax(const float* W, int N, const float* gain, LAS float* red) {
    float mx = 0.f;
    for (int idx = threadIdx.x; idx < N; idx += NTHREADS) {
#pragma unroll
        for (int k = 0; k < 4; ++k) mx = fmaxf(mx, fabsf(W[(size_t)k * N + idx] * (gain ? gain[k] : 1.0f)));
    }
#pragma unroll
    for (int o = 1; o < 64; o <<= 1) mx = fmaxf(mx, __shfl_xor(mx, o));
    __syncthreads();
    if ((threadIdx.x & 63) == 0) red[threadIdx.x >> 6] = mx;
    __syncthreads();
    float r = red[0];
#pragma unroll
    for (int w = 1; w < NWAVES; ++w) r = fmaxf(r, red[w]);
    return r;
}
DI void transpose_item(const float* W, int K, int N, bf16* WT, int ldt, int row_off, const float* gain, LAS float* scr, int item, int lane) {
    const int nblk = N / 64, kb = item / nblk, nb = item % nblk, k0 = 64 * kb, n0 = 64 * nb;
    const int kr = lane >> 4, nc = (lane & 15) * 4;
    f32x4 v[16]; float g[16];
#pragma unroll
    for (int i = 0; i < 16; ++i) { v[i] = __builtin_nontemporal_load((const f32x4*)(W + (size_t)(k0 + 4 * i + kr) * N + n0 + nc)); g[i] = gain ? gain[k0 + 4 * i + kr] : 1.0f; }
#pragma unroll
    for (int i = 0; i < 16; ++i) { LAS float* d = scr + (4 * i + kr) * 65 + nc; d[0] = v[i].x * g[i]; d[1] = v[i].y * g[i]; d[2] = v[i].z * g[i]; d[3] = v[i].w * g[i]; }
    asm volatile("s_waitcnt lgkmcnt(0)" ::: "memory");
    const int c = lane & 7;
#pragma unroll
    for (int j = 0; j < 8; ++j) { const int n = (lane >> 3) + 8 * j; const LAS float* s = scr + (8 * c) * 65 + n;
        v4u o; o.x = pk2(s[0 * 65], s[1 * 65]); o.y = pk2(s[2 * 65], s[3 * 65]); o.z = pk2(s[4 * 65], s[5 * 65]); o.w = pk2(s[6 * 65], s[7 * 65]);
        *(v4u*)(WT + (size_t)(row_off + n0 + n) * ldt + k0 + 8 * c) = o; }
    asm volatile("s_waitcnt lgkmcnt(0)" ::: "memory");
}

constexpr int ATT_PITCH = 272;
constexpr int ATT_SLOT = 256 * ATT_PITCH;
constexpr int ATT_ITEMS = 1024 + 768;
DI int crow(int reg, int h) { return (reg & 3) + 8 * (reg >> 2) + 4 * h; }

struct AttItem { int qcol, kcol, vcol, dil, res, n, maxd, old, hh, g; float sink; bf16* obase; bool has_lse; };
DI AttItem att_decode(int it, const float* sinks, unsigned char* ycat, bf16* outg) {
    AttItem a; a.hh = 0; a.g = 0;
    if (it < 1024) {
        const int qh = it >> 6; a.n = it & 63; a.qcol = COL_QA + qh * 128; a.kcol = COL_KA + (qh >> 2) * 128; a.vcol = COL_VA + (qh >> 2) * 128;
        a.dil = 1; a.res = 0; a.maxd = 127; a.sink = sinks[qh]; a.obase = (bf16*)(ycat + 512 + qh * 128); a.old = YCW; a.has_lse = false;
    } else {
        const int j = it - 1024; a.g = j >> 8; const int rem = j & 255; a.hh = rem >> 6; const int blk = rem & 63;
        a.dil = (a.g == 0) ? 1 : (a.g == 1 ? 4 : 16); a.res = blk % a.dil; a.n = blk / a.dil;
        const int hb = 4 * a.g + a.hh; a.qcol = COL_QB + hb * 128; a.kcol = COL_KB + hb * 128; a.vcol = COL_VB + hb * 128;
        a.maxd = 128; a.sink = -__builtin_inff(); a.obase = outg + (size_t)a.g * SEQ * 512 + a.hh * 128; a.old = 512; a.has_lse = true;
    }
    return a;
}
DI void att_fetch(v4u (&w)[16], const bf16* proj, int col, int dil, int res, int n, int st) {
    const int ch = st & 15, r0 = st >> 4;
    const size_t rstep = (size_t)16 * dil * INW;
#pragma unroll
    for (int hb = 0; hb < 2; ++hb) {
        if (n > 0 || hb == 1) {
            const bf16* gp = proj + (size_t)(res + dil * (128 * (n - 1) + 128 * hb + r0)) * INW + col + ch * 8;
#pragma unroll
            for (int ps = 0; ps < 8; ++ps) w[hb * 8 + ps] = *(const v4u*)(gp + ps * rstep);
        } else {
#pragma unroll
            for (int ps = 0; ps < 8; ++ps) w[hb * 8 + ps] = (v4u){0u, 0u, 0u, 0u};
        }
    }
}
DI void att_store(LAS unsigned char* slot, const v4u (&w)[16], int st) {
    LAS unsigned char* lp = slot + (st >> 4) * ATT_PITCH + (st & 15) * 16;
#pragma unroll
    for (int ps = 0; ps < 16; ++ps) *(LAS v4u*)(lp + ps * 16 * ATT_PITCH) = w[ps];
}

DI void attention_phase(LAS unsigned char* lds, const bf16* proj, const float* sinks, unsigned char* ycat, bf16* outg, float* lse, int bid, int G) {
    const int tid = threadIdx.x, lane = tid & 63, wave = __builtin_amdgcn_readfirstlane(tid >> 6);
    const int slot_id = wave >> 2, w = wave & 3, st = tid & 255;
    const int r = lane & 31, h = lane >> 5;
    LAS unsigned char* slot = lds + slot_id * ATT_SLOT;
    const float c_scale = 0.08838834764831845f, LOG2E = 1.4426950408889634f;
    v4u kw[16];
    if (bid < ATT_ITEMS / 2) { const AttItem a0 = att_decode(2 * bid + slot_id, sinks, ycat, outg); att_fetch(kw, proj, a0.kcol, a0.dil, a0.res, a0.n, st); }
#pragma unroll 1
    for (int pair = bid; pair < ATT_ITEMS / 2; pair += G) {
        const AttItem a = att_decode(2 * pair + slot_id, sinks, ycat, outg);
        const int n = a.n;
        att_store(slot, kw, st);
        const int iq = 128 * n + 32 * w + r, qpos = a.res + a.dil * iq;
        bf16x8 qf[8];
#pragma unroll
        for (int ks = 0; ks < 8; ++ks) qf[ks] = *(const bf16x8*)(proj + (size_t)qpos * INW + a.qcol + 16 * ks + 8 * h);
        __syncthreads();
        f32x16 sacc[5];
#pragma unroll
        for (int kbi = 0; kbi < 5; ++kbi) {
#pragma unroll
            for (int i = 0; i < 16; ++i) sacc[kbi][i] = 0.f;
#pragma unroll
            for (int ks = 0; ks < 8; ++ks) {
                const bf16x8 af = *(const LAS bf16x8*)(slot + (32 * (w + kbi) + r) * ATT_PITCH + (16 * ks + 8 * h) * 2);
                sacc[kbi] = __builtin_amdgcn_mfma_f32_32x32x16_bf16(af, qf[ks], sacc[kbi], 0, 0, 0);
            }
            asm volatile("" ::: "memory");
        }
        v4u vw[16];
        att_fetch(vw, proj, a.vcol, a.dil, a.res, n, st);
        int base = r - 4 * h; asm volatile("" : "+v"(base));
        const int lim = (n > 0) ? a.maxd : min(a.maxd, 32 * w + r);
        float mx = -__builtin_inff();
#pragma unroll
        for (int kbi = 0; kbi < 5; ++kbi)
#pragma unroll
            for (int i = 0; i < 16; ++i) {
                const int dist = base + (128 - 32 * kbi - (i & 3) - 8 * (i >> 2));
                const bool valid = (unsigned)dist <= (unsigned)lim;
                const float s = valid ? sacc[kbi][i] : -__builtin_inff();
                sacc[kbi][i] = s; mx = fmaxf(mx, s);
            }
        mx = fmaxf(mx, __shfl_xor(mx, 32));
        const float m_sc = fmaxf(mx * c_scale, a.sink);
        const float mb = m_sc * LOG2E, c2 = c_scale * LOG2E;
        float l = 0.f;
#pragma unroll
        for (int kbi = 0; kbi < 5; ++kbi)
#pragma unroll
            for (int i = 0; i < 16; ++i) { const float p = __builtin_amdgcn_exp2f(sacc[kbi][i] * c2 - mb); sacc[kbi][i] = p; l += p; }
        l += __shfl_xor(l, 32);
        l += __builtin_amdgcn_exp2f(a.sink * LOG2E - mb);
        const float rl = 1.0f / l;
        if (a.has_lse && h == 0) lse[((size_t)a.g * SEQ + qpos) * 4 + a.hh] = m_sc + __logf(l);
        bf16x8 pf[5][2];
#pragma unroll
        for (int kbi = 0; kbi < 5; ++kbi)
#pragma unroll
            for (int s = 0; s < 2; ++s) {
                v4u pw; pw.x = pk2(sacc[kbi][8 * s + 0], sacc[kbi][8 * s + 1]); pw.y = pk2(sacc[kbi][8 * s + 2], sacc[kbi][8 * s + 3]);
                pw.z = pk2(sacc[kbi][8 * s + 4], sacc[kbi][8 * s + 5]); pw.w = pk2(sacc[kbi][8 * s + 6], sacc[kbi][8 * s + 7]);
                pf[kbi][s] = __builtin_bit_cast(bf16x8, pw);
            }
        __syncthreads();
        att_store(slot, vw, st);
        __syncthreads();
        { const int pnx = (pair + G < ATT_ITEMS / 2) ? pair + G : pair;
          const AttItem an = att_decode(2 * pnx + slot_id, sinks, ycat, outg); att_fetch(kw, proj, an.kcol, an.dil, an.res, an.n, st); }
        f32x16 oacc[4];
#pragma unroll
        for (int db = 0; db < 4; ++db)
#pragma unroll
            for (int i = 0; i < 16; ++i) oacc[db][i] = 0.f;
        const int q4 = (lane & 15) >> 2, p4 = lane & 3, blk16 = (lane >> 4) & 1;
#pragma unroll
        for (int kbi = 0; kbi < 5; ++kbi)
#pragma unroll
            for (int s = 0; s < 2; ++s) {
                const int key0 = 32 * (w + kbi) + 16 * s + 4 * h + q4;
#pragma unroll
                for (int db = 0; db < 4; ++db) {
                    const LAS unsigned char* a0 = slot + key0 * ATT_PITCH + (32 * db + 16 * blk16) * 2 + 8 * p4;
                    const s16x4 lo = __builtin_amdgcn_ds_read_tr16_b64_v4i16((LAS s16x4*)a0);
                    const s16x4 hi = __builtin_amdgcn_ds_read_tr16_b64_v4i16((LAS s16x4*)(a0 + 8 * ATT_PITCH));
                    const bf16x8 va = __builtin_shufflevector(lo, hi, 0, 1, 2, 3, 4, 5, 6, 7);
                    oacc[db] = __builtin_amdgcn_mfma_f32_32x32x16_bf16(va, pf[kbi][s], oacc[db], 0, 0, 0);
                }
                asm volatile("" ::: "memory");
            }
        if (a.has_lse) {
            bf16* orow = a.obase + (size_t)qpos * a.old;
#pragma unroll
            for (int db = 0; db < 4; ++db) {
                v2u o[4];
#pragma unroll
                for (int g4 = 0; g4 < 4; ++g4) { o[g4].x = pk2(oacc[db][4 * g4 + 0] * rl, oacc[db][4 * g4 + 1] * rl); o[g4].y = pk2(oacc[db][4 * g4 + 2] * rl, oacc[db][4 * g4 + 3] * rl); }
                const auto s02x = __builtin_amdgcn_permlane32_swap(o[0].x, o[2].x, false, false), s02y = __builtin_amdgcn_permlane32_swap(o[0].y, o[2].y, false, false);
                const auto s13x = __builtin_amdgcn_permlane32_swap(o[1].x, o[3].x, false, false), s13y = __builtin_amdgcn_permlane32_swap(o[1].y, o[3].y, false, false);
                *(v4u*)(orow + 32 * db + 16 * h) = (v4u){s02x[0], s02y[0], s02x[1], s02y[1]};
                *(v4u*)(orow + 32 * db + 16 * h + 8) = (v4u){s13x[0], s13y[0], s13x[1], s13y[1]};
            }
        } else {
            unsigned char* orow = (unsigned char*)a.obase + (size_t)qpos * a.old; const float rs = rl * YSCALE;
#pragma unroll
            for (int db = 0; db < 4; ++db) {
                unsigned d[4];
#pragma unroll
                for (int g4 = 0; g4 < 4; ++g4) d[g4] = pk4_fp8(oacc[db][4 * g4 + 0] * rs, oacc[db][4 * g4 + 1] * rs, oacc[db][4 * g4 + 2] * rs, oacc[db][4 * g4 + 3] * rs);
                const auto s02 = __builtin_amdgcn_permlane32_swap(d[0], d[2], false, false), s13 = __builtin_amdgcn_permlane32_swap(d[1], d[3], false, false);
                *(v4u*)(orow + 32 * db + 16 * h) = (v4u){s02[0], s02[1], s13[0], s13[1]};
            }
        }
        __syncthreads();
    }
}

DI void combine_phase(const bf16* outg, const float* lse, unsigned char* ycat, int gtid, int gthreads) {
    for (int idx = gtid; idx < SEQ * 64; idx += gthreads) {
        const int t = idx >> 6, ch = idx & 63, hh = ch >> 4, dd = (ch & 15) * 8;
        const float l0 = lse[((size_t)0 * SEQ + t) * 4 + hh], l1 = lse[((size_t)1 * SEQ + t) * 4 + hh], l2 = lse[((size_t)2 * SEQ + t) * 4 + hh];
        const float m = fmaxf(l0, fmaxf(l1, l2));
        float w0 = __expf(l0 - m), w1 = __expf(l1 - m), w2 = __expf(l2 - m); const float rs = 1.0f / (w0 + w1 + w2); w0 *= rs; w1 *= rs; w2 *= rs;
        const v4u a = *(const v4u*)(outg + ((size_t)0 * SEQ + t) * 512 + hh * 128 + dd);
        const v4u b = *(const v4u*)(outg + ((size_t)1 * SEQ + t) * 512 + hh * 128 + dd);
        const v4u c = *(const v4u*)(outg + ((size_t)2 * SEQ + t) * 512 + hh * 128 + dd);
        w0 *= YSCALE; w1 *= YSCALE; w2 *= YSCALE;
        v2u o;
        o.x = pk4_fp8(w0 * bflo(a.x) + w1 * bflo(b.x) + w2 * bflo(c.x), w0 * bfhi(a.x) + w1 * bfhi(b.x) + w2 * bfhi(c.x), w0 * bflo(a.y) + w1 * bflo(b.y) + w2 * bflo(c.y), w0 * bfhi(a.y) + w1 * bfhi(b.y) + w2 * bfhi(c.y));
        o.y = pk4_fp8(w0 * bflo(a.z) + w1 * bflo(b.z) + w2 * bflo(c.z), w0 * bfhi(a.z) + w1 * bfhi(b.z) + w2 * bfhi(c.z), w0 * bflo(a.w) + w1 * bflo(b.w) + w2 * bflo(c.w), w0 * bfhi(a.w) + w1 * bfhi(b.w) + w2 * bfhi(c.w));
        *(v2u*)(ycat + (size_t)t * YCW + hh * 128 + dd) = o;
    }
}

constexpr int RT_PITCH = 129;
DI int f2key(float f) { const int b = __builtin_bit_cast(int, f); return b ^ ((b >> 31) & 0x7fffffff); }
DI float key2f(int k) { const int b = k ^ ((k >> 31) & 0x7fffffff); return __builtin_bit_cast(float, b); }
#define TOPK_INSERT(arr, xx) do { int _x = (xx); _Pragma("unroll") for (int _j = 0; _j < 16; ++_j) { const int _hi = max(arr[_j], _x); _x = min(arr[_j], _x); arr[_j] = _hi; } } while (0)

DI void routing_block(LAS unsigned char* lds, const bf16* q, const bf16* skb, int* experts, float* pgates, int tb) {
    int tid = threadIdx.x; asm volatile("" : "+v"(tid));
    const int lane = tid & 63, wave = __builtin_amdgcn_readfirstlane(tid >> 6);
    const int r = lane & 31, h = lane >> 5;
    LAS int* sc = (LAS int*)lds;
#pragma unroll 1
    for (int hp = 0; hp < 2; ++hp) {
        const int t0 = tb * 32, hc = 8 * hp + wave;
        f32x16 acc[4];
#pragma unroll
        for (int kb = 0; kb < 4; ++kb)
#pragma unroll
            for (int i = 0; i < 16; ++i) acc[kb][i] = 0.f;
#pragma unroll
        for (int ks = 0; ks < 8; ++ks) {
            const bf16x8 a = *(const bf16x8*)(q + (size_t)(t0 + r) * QW + hc * 128 + 16 * ks + 8 * h);
#pragma unroll
            for (int kb = 0; kb < 4; ++kb) {
                const bf16x8 b = *(const bf16x8*)(skb + ((size_t)hc * 128 + 32 * kb + r) * 128 + 16 * ks + 8 * h);
                acc[kb] = __builtin_amdgcn_mfma_f32_32x32x16_bf16(a, b, acc[kb], 0, 0, 0);
            }
        }
#pragma unroll
        for (int kb = 0; kb < 4; ++kb)
#pragma unroll
            for (int i = 0; i < 16; ++i) {
                const int key = 32 * kb + r;
                sc[(crow(i, h) * 8 + wave) * RT_PITCH + key] = (f2key(acc[kb][i]) & ~127) | key;
            }
        __syncthreads();
        {
            int a[16];
#pragma unroll
            for (int j = 0; j < 16; ++j) a[j] = (int)0x80000000;
            LAS int* row = sc + (tid >> 1) * RT_PITCH; const int hf = tid & 1;
#pragma unroll 8
            for (int k = 0; k < 64; ++k) { const int x = row[64 * hf + k]; TOPK_INSERT(a, x); }
            __syncthreads();
#pragma unroll
            for (int j = 0; j < 16; ++j) row[16 * hf + j] = a[j];
            __syncthreads();
            if (hf == 0) {
#pragma unroll
                for (int j = 0; j < 16; ++j) { const int x = row[16 + j]; TOPK_INSERT(a, x); }
#pragma unroll
                for (int j = 0; j < 16; ++j) row[j] = a[j];
            }
        }
        __syncthreads();
        if (tid < 128) {
            LAS int* ra = sc + (2 * tid) * RT_PITCH; LAS int* rb = ra + RT_PITCH;
            float va[16], vb[16];
#pragma unroll
            for (int j = 0; j < 16; ++j) { va[j] = key2f(ra[j] & ~127); vb[j] = key2f(rb[j] & ~127); }
            int c[16];
#pragma unroll
            for (int j = 0; j < 16; ++j) c[j] = (int)0x80000000;
#pragma unroll
            for (int i = 0; i < 16; ++i)
#pragma unroll
                for (int j = 0; j < 16; ++j)
                    if ((i + 1) * (j + 1) <= 16) { const int x = (f2key(va[i] + vb[j]) & ~255) | (i * 16 + j); TOPK_INSERT(c, x); }
            int ex[16];
#pragma unroll
            for (int k = 0; k < 16; ++k) { const int id = c[k] & 255; ex[k] = (ra[id >> 4] & 127) * 128 + (rb[id & 15] & 127); }
            float e[16]; const float m0 = key2f(c[0] & ~255); float s2 = 0.f;
#pragma unroll
            for (int k = 0; k < 16; ++k) { e[k] = __expf(key2f(c[k] & ~255) - m0); s2 += e[k]; }
            const float rs = 1.0f / s2;
            const int t = t0 + (tid >> 2), hd = 4 * hp + (tid & 3);
            int* ep = experts + (size_t)t * 128 + hd * 16; float* gp = pgates + (size_t)t * 128 + hd * 16;
#pragma unroll
            for (int k4 = 0; k4 < 4; ++k4) {
                *(int4*)(ep + 4 * k4) = make_int4(ex[4 * k4], ex[4 * k4 + 1], ex[4 * k4 + 2], ex[4 * k4 + 3]);
                *(f32x4*)(gp + 4 * k4) = (f32x4){e[4 * k4] * rs, e[4 * k4 + 1] * rs, e[4 * k4 + 2] * rs, e[4 * k4 + 3] * rs};
            }
        }
        __syncthreads();
    }
}

typedef float f32x32 __attribute__((ext_vector_type(32)));
typedef unsigned v6u __attribute__((ext_vector_type(6)));
typedef unsigned v16u __attribute__((ext_vector_type(16)));
typedef __bf16 bf16x32 __attribute__((ext_vector_type(32)));
constexpr int ROW4 = 2048, RSLOT = 2 * ROW4;
DI float readlane_f(float v, int l) { return __builtin_bit_cast(float, __builtin_amdgcn_readlane(__builtin_bit_cast(int, v), l)); }
DI float wave_sum_dpp(float v) {
#define DPPF(x, ctrl, rmask) __builtin_bit_cast(float, __builtin_amdgcn_update_dpp(0, __builtin_bit_cast(int, x), ctrl, rmask, 0xf, false))
    v += DPPF(v, 0xB1, 0xf); v += DPPF(v, 0x4E, 0xf); v += DPPF(v, 0x141, 0xf); v += DPPF(v, 0x140, 0xf);
    v += DPPF(v, 0x142, 0xa); v += DPPF(v, 0x143, 0xc);
#undef DPPF
    return readlane_f(v, 63);
}
DI float gelu_exact(float v) {
    const float av = fabsf(v), t = __builtin_amdgcn_rcpf(av * 0.2316418882f + 1.0f);
    float q = t * 0.5307027145f + (-0.7265760135f); q = q * t + 0.7107068705f; q = q * t + (-0.142248368f); q = q * t + 0.127414796f; q = q * t;
    const float e = __builtin_amdgcn_exp2f((v * v) * (-0.72134752044f));
    const float m = v * (q * e);
    return v < 0.f ? m : v - m;
}
#define P11_DMA(gsrc, ldst, NP) do { _Pragma("unroll") for (int _i = 0; _i < (NP); ++_i) \
    __builtin_amdgcn_global_load_lds((const unsigned*)((gsrc) + _i * 1024), (LAS unsigned*)((ldst) + _i * 1024), 16, 0, 0); } while (0)
DI void peer_token(LAS unsigned char* ring, const bf16* x1row, float inv2, const float* nffn, const int* ex, const float* pg, const unsigned char* U6, const unsigned char* V6,
                   const float* usc, const float* vsc, float* orow, int lane) {
    unsigned k0 = ((unsigned)__hip_atomic_load(ex + lane, __ATOMIC_RELAXED, __HIP_MEMORY_SCOPE_AGENT) << 7) | (unsigned)lane;
    unsigned k1 = ((unsigned)__hip_atomic_load(ex + 64 + lane, __ATOMIC_RELAXED, __HIP_MEMORY_SCOPE_AGENT) << 7) | (unsigned)(64 + lane);
#define P11_CX(J, ASC0, ASC1) do { const unsigned o0_ = (unsigned)__shfl_xor((int)k0, (J)), o1_ = (unsigned)__shfl_xor((int)k1, (J)); const bool lowl_ = (lane & (J)) == 0; \
        k0 = (lowl_ == (ASC0)) ? (k0 < o0_ ? k0 : o0_) : (k0 > o0_ ? k0 : o0_); k1 = (lowl_ == (ASC1)) ? (k1 < o1_ ? k1 : o1_) : (k1 > o1_ ? k1 : o1_); } while (0)
#pragma unroll
    for (int kk = 2; kk <= 32; kk <<= 1) { const bool asc = (lane & kk) == 0;
#pragma unroll
        for (int j = kk >> 1; j >= 1; j >>= 1) P11_CX(j, asc, asc); }
#pragma unroll
    for (int j = 32; j >= 1; j >>= 1) P11_CX(j, true, false);
    { const unsigned lo_ = k0 < k1 ? k0 : k1, hi_ = k0 < k1 ? k1 : k0; k0 = lo_; k1 = hi_; }
#pragma unroll
    for (int j = 32; j >= 1; j >>= 1) P11_CX(j, true, true);
#undef P11_CX
    const int e_lo = (int)(k0 >> 7), e_hi = (int)(k1 >> 7);
    const float us_lo = usc[e_lo], us_hi = usc[e_hi];
    const float gv_lo = __hip_atomic_load(pg + (k0 & 127u), __ATOMIC_RELAXED, __HIP_MEMORY_SCOPE_AGENT) * vsc[e_lo], gv_hi = __hip_atomic_load(pg + (k1 & 127u), __ATOMIC_RELAXED, __HIP_MEMORY_SCOPE_AGENT) * vsc[e_hi];
    f32x2 h2[32], y[32];
    asm volatile("" : "+s"(nffn));
#pragma unroll
    for (int i = 0; i < 16; ++i) {
        const v2u aw = *(const v2u*)(x1row + i * 256 + lane * 4); const f32x4 g = *(const f32x4*)(nffn + i * 256 + lane * 4);
        h2[2 * i] = (f32x2){bflo(aw.x) * inv2 * g.x, bfhi(aw.x) * inv2 * g.y}; h2[2 * i + 1] = (f32x2){bflo(aw.y) * inv2 * g.z, bfhi(aw.y) * inv2 * g.w};
    }
#pragma unroll
    for (int i = 0; i < 32; ++i) y[i] = (f32x2){0.f, 0.f};
    asm volatile("s_waitcnt vmcnt(0)" ::: "memory");
    const unsigned char* ul = U6 + lane * 16; const unsigned char* vl = V6 + lane * 16;
    {
#pragma unroll
        for (int j = 0; j < 8; ++j) { const int ej = __builtin_amdgcn_readlane(e_lo, j); P11_DMA(ul + (size_t)ej * ROW4, ring + j * ROW4, 2); }
    }
    float cf_lo = 0.f, cf_hi = 0.f;
#define P11_ROW(k, NEXT_BASE, NEXT_REG, NEXT_LANE, W) \
        LAS unsigned char* su = ring + ((k) & 7) * ROW4; \
        const int en = __builtin_amdgcn_readlane(NEXT_REG, NEXT_LANE); \
        asm volatile("s_waitcnt vmcnt(14)" ::: "memory");            \
        v4u W[2]; \
        _Pragma("unroll") for (int i = 0; i < 2; ++i) W[i] = *(const LAS v4u*)(su + i * 1024 + lane * 16); \
        asm volatile("s_waitcnt lgkmcnt(0)" ::: "memory"); \
        P11_DMA((NEXT_BASE) + (size_t)en * ROW4, su, 2);
#define P11_U(k, US_REG, GV_REG, CF_REG, NEXT_BASE, NEXT_REG, NEXT_LANE) do { \
        P11_ROW(k, NEXT_BASE, NEXT_REG, NEXT_LANE, uw) \
        const float usk = readlane_f(US_REG, (k) & 63), gvk = readlane_f(GV_REG, (k) & 63); \
        f32x2 d0 = {0.f, 0.f}, d1 = {0.f, 0.f}, d2 = {0.f, 0.f}, d3 = {0.f, 0.f}; \
        { const unsigned w8[8] = {uw[0].x, uw[0].y, uw[0].z, uw[0].w, uw[1].x, uw[1].y, uw[1].z, uw[1].w}; \
          _Pragma("unroll") for (int w = 0; w < 8; ++w) { \
            d0 = __builtin_amdgcn_cvt_scalef32_pk_f32_fp4(w8[w], 1.0f, 0) * h2[4 * w + 0] + d0; d1 = __builtin_amdgcn_cvt_scalef32_pk_f32_fp4(w8[w], 1.0f, 1) * h2[4 * w + 1] + d1; \
            d2 = __builtin_amdgcn_cvt_scalef32_pk_f32_fp4(w8[w], 1.0f, 2) * h2[4 * w + 2] + d2; d3 = __builtin_amdgcn_cvt_scalef32_pk_f32_fp4(w8[w], 1.0f, 3) * h2[4 * w + 3] + d3; } } \
        const f32x2 ds = (d0 + d1) + (d2 + d3); \
        const float d = wave_sum_dpp(ds.x + ds.y) * usk; \
        const float cf = gelu_exact(d) * gvk; \
        CF_REG = (lane == ((k) & 63)) ? cf : CF_REG; } while (0)
#define P11_V(k, CF_REG, NEXT_BASE, NEXT_REG, NEXT_LANE) do { \
        P11_ROW(k, NEXT_BASE, NEXT_REG, NEXT_LANE, vw) \
        const float cfk = readlane_f(CF_REG, (k) & 63); const f32x2 cf2_ = {cfk, cfk}; \
        const unsigned w8_[8] = {vw[0].x, vw[0].y, vw[0].z, vw[0].w, vw[1].x, vw[1].y, vw[1].z, vw[1].w}; \
        _Pragma("unroll") for (int w_ = 0; w_ < 8; ++w_) { \
            y[4 * w_ + 0] = __builtin_amdgcn_cvt_scalef32_pk_f32_fp4(w8_[w_], 1.0f, 0) * cf2_ + y[4 * w_ + 0]; y[4 * w_ + 1] = __builtin_amdgcn_cvt_scalef32_pk_f32_fp4(w8_[w_], 1.0f, 1) * cf2_ + y[4 * w_ + 1]; \
            y[4 * w_ + 2] = __builtin_amdgcn_cvt_scalef32_pk_f32_fp4(w8_[w_], 1.0f, 2) * cf2_ + y[4 * w_ + 2]; y[4 * w_ + 3] = __builtin_amdgcn_cvt_scalef32_pk_f32_fp4(w8_[w_], 1.0f, 3) * cf2_ + y[4 * w_ + 3]; } } while (0)
#pragma unroll 2
    for (int k = 0; k < 56; ++k) P11_U(k, us_lo, gv_lo, cf_lo, ul, e_lo, k + 8);
#pragma unroll 1
    for (int k = 56; k < 64; ++k) P11_U(k, us_lo, gv_lo, cf_lo, ul, e_hi, k - 56);
#pragma unroll 2
    for (int k = 64; k < 120; ++k) P11_U(k, us_hi, gv_hi, cf_hi, ul, e_hi, k - 56);
#pragma unroll 1
    for (int k = 120; k < 128; ++k) P11_U(k, us_hi, gv_hi, cf_hi, vl, e_lo, k - 120);
#pragma unroll 1
    for (int k = 0; k < 56; ++k) P11_V(k, cf_lo, vl, e_lo, k + 8);
#pragma unroll 1
    for (int k = 56; k < 64; ++k) P11_V(k, cf_lo, vl, e_hi, k - 56);
#pragma unroll 1
    for (int k = 64; k < 120; ++k) P11_V(k, cf_hi, vl, e_hi, k - 56);
#pragma unroll 1
    for (int k = 120; k < 128; ++k) P11_V(k, cf_hi, vl, e_lo, k - 120);
#undef P11_ROW
#undef P11_U
#undef P11_V
    const float ysc = 1.0f;
    asm volatile("s_waitcnt vmcnt(0)" ::: "memory");
#pragma unroll
    for (int i = 0; i < 16; ++i) {
        const v2u aw = *(const v2u*)(x1row + i * 256 + lane * 4);
        *(f32x4*)(orow + i * 256 + lane * 4) = (f32x4){bflo(aw.x) + ysc * y[2 * i].x, bfhi(aw.x) + ysc * y[2 * i].y, bflo(aw.y) + ysc * y[2 * i + 1].x, bfhi(aw.y) + ysc * y[2 * i + 1].y};
    }
}
DI void row_load(const float* xrow, f32x4 (&v)[16], int lane) {
#pragma unroll
    for (int i = 0; i < 16; ++i) v[i] = __builtin_nontemporal_load((const f32x4*)(xrow + i * 256 + lane * 4));
}
DI void row_emit_fp4(const f32x4 (&v)[16], unsigned char* orow, float* sc_out, int lane);
DI void row_to_fp4(const float* xrow, unsigned char* orow, float* sc_out, int lane) { f32x4 v[16]; row_load(xrow, v, lane); row_emit_fp4(v, orow, sc_out, lane); }
DI void row_emit_fp4(const f32x4 (&v)[16], unsigned char* orow, float* sc_out, int lane) {
    float mx = 0.f, ss = 0.f;
#pragma unroll
    for (int i = 0; i < 16; ++i) { const f32x4 a = v[i];
        mx = fmaxf(mx, fmaxf(fmaxf(fabsf(a.x), fabsf(a.y)), fmaxf(fabsf(a.z), fabsf(a.w)))); ss += (a.x * a.x + a.y * a.y) + (a.z * a.z + a.w * a.w); }
#pragma unroll
    for (int o = 1; o < 64; o <<= 1) { mx = fmaxf(mx, __shfl_xor(mx, o)); ss += __shfl_xor(ss, o); }
    const float top = fminf(mx, 3.0f * sqrtf(ss * (1.0f / DM)));
    const float s = top > 0.f ? 6.0f / top : 1.0f;
    if (lane == 0) *sc_out = top > 0.f ? top * (1.0f / 6.0f) : 1.0f;
    unsigned pk[8];
#pragma unroll
    for (int w = 0; w < 8; ++w) {
        unsigned p = 0;
#define SAT6(x) fminf(fmaxf((x), -6.0f), 6.0f)
        p = __builtin_amdgcn_cvt_scalef32_pk_fp4_f32(p, SAT6(v[2 * w].x * s), SAT6(v[2 * w].y * s), 1.0f, 0);
        p = __builtin_amdgcn_cvt_scalef32_pk_fp4_f32(p, SAT6(v[2 * w].z * s), SAT6(v[2 * w].w * s), 1.0f, 1);
        p = __builtin_amdgcn_cvt_scalef32_pk_fp4_f32(p, SAT6(v[2 * w + 1].x * s), SAT6(v[2 * w + 1].y * s), 1.0f, 2);
        p = __builtin_amdgcn_cvt_scalef32_pk_fp4_f32(p, SAT6(v[2 * w + 1].z * s), SAT6(v[2 * w + 1].w * s), 1.0f, 3);
#undef SAT6
        pk[w] = p;
    }
#pragma unroll
    for (int p = 0; p < 2; ++p) *(v4u*)(orow + p * 1024 + lane * 16) = (v4u){pk[4 * p], pk[4 * p + 1], pk[4 * p + 2], pk[4 * p + 3]};
}
DI void xrow_to_fp8(const float* xrow, unsigned char* orow, float* rowf_out, unsigned char* orow4, float* rowf4_out, int lane) {
    f32x4 v[16]; float mx = 0.f, ss = 0.f;
#pragma unroll
    for (int i = 0; i < 4; ++i)
#pragma unroll
        for (int jj = 0; jj < 4; ++jj) { const f32x4 a = *(const f32x4*)(xrow + i * 1024 + lane * 16 + jj * 4); v[i * 4 + jj] = a;
            mx = fmaxf(mx, fmaxf(fmaxf(fabsf(a.x), fabsf(a.y)), fmaxf(fabsf(a.z), fabsf(a.w)))); ss += (a.x * a.x + a.y * a.y) + (a.z * a.z + a.w * a.w); }
#pragma unroll
    for (int o = 1; o < 64; o <<= 1) { mx = fmaxf(mx, __shfl_xor(mx, o)); ss += __shfl_xor(ss, o); }
    const float s = mx > 0.f ? 256.0f / mx : 1.0f;
    const float rms = sqrtf(ss * (1.0f / DM)), inv = 1.0f / sqrtf(ss * (1.0f / DM) + EPS);
    const float top4 = fminf(mx, 3.0f * rms), s4 = top4 > 0.f ? 6.0f / top4 : 1.0f;
    if (lane == 0) { *rowf_out = (mx > 0.f ? mx * (1.0f / 256.0f) : 1.0f) * inv; *rowf4_out = (top4 > 0.f ? top4 * (1.0f / 6.0f) : 1.0f) * inv; }
#pragma unroll
    for (int i = 0; i < 4; ++i) {
        v4u o;
        o.x = pk4_fp8(v[i * 4 + 0].x * s, v[i * 4 + 0].y * s, v[i * 4 + 0].z * s, v[i * 4 + 0].w * s); o.y = pk4_fp8(v[i * 4 + 1].x * s, v[i * 4 + 1].y * s, v[i * 4 + 1].z * s, v[i * 4 + 1].w * s);
        o.z = pk4_fp8(v[i * 4 + 2].x * s, v[i * 4 + 2].y * s, v[i * 4 + 2].z * s, v[i * 4 + 2].w * s); o.w = pk4_fp8(v[i * 4 + 3].x * s, v[i * 4 + 3].y * s, v[i * 4 + 3].z * s, v[i * 4 + 3].w * s);
        *(v4u*)(orow + i * 1024 + lane * 16) = o;
#define SAT6(x) fminf(fmaxf((x), -6.0f), 6.0f)
        v2u q;
        { unsigned p = 0; p = __builtin_amdgcn_cvt_scalef32_pk_fp4_f32(p, SAT6(v[i * 4 + 0].x * s4), SAT6(v[i * 4 + 0].y * s4), 1.0f, 0); p = __builtin_amdgcn_cvt_scalef32_pk_fp4_f32(p, SAT6(v[i * 4 + 0].z * s4), SAT6(v[i * 4 + 0].w * s4), 1.0f, 1);
          p = __builtin_amdgcn_cvt_scalef32_pk_fp4_f32(p, SAT6(v[i * 4 + 1].x * s4), SAT6(v[i * 4 + 1].y * s4), 1.0f, 2); p = __builtin_amdgcn_cvt_scalef32_pk_fp4_f32(p, SAT6(v[i * 4 + 1].z * s4), SAT6(v[i * 4 + 1].w * s4), 1.0f, 3); q.x = p; }
        { unsigned p = 0; p = __builtin_amdgcn_cvt_scalef32_pk_fp4_f32(p, SAT6(v[i * 4 + 2].x * s4), SAT6(v[i * 4 + 2].y * s4), 1.0f, 0); p = __builtin_amdgcn_cvt_scalef32_pk_fp4_f32(p, SAT6(v[i * 4 + 2].z * s4), SAT6(v[i * 4 + 2].w * s4), 1.0f, 1);
          p = __builtin_amdgcn_cvt_scalef32_pk_fp4_f32(p, SAT6(v[i * 4 + 3].x * s4), SAT6(v[i * 4 + 3].y * s4), 1.0f, 2); p = __builtin_amdgcn_cvt_scalef32_pk_fp4_f32(p, SAT6(v[i * 4 + 3].z * s4), SAT6(v[i * 4 + 3].w * s4), 1.0f, 3); q.y = p; }
#undef SAT6
        *(v2u*)(orow4 + i * 512 + lane * 8) = q;
    }
}
#ifndef LATE_ROWS
#define LATE_ROWS 16
#endif
struct Args { const void* in[19]; float* out; unsigned char* ws; int ph_lo, ph_hi; };
DI void conv_rows(LAS unsigned char* lds, int m_lo, int m_hi) {
    const __attribute__((address_space(4))) Args* ka = (const __attribute__((address_space(4))) Args*)__builtin_amdgcn_kernarg_segment_ptr();
    asm volatile("" : "+s"(ka));
    int tid = threadIdx.x; asm volatile("" : "+v"(tid));
    const int lane = tid & 63, wave = __builtin_amdgcn_readfirstlane(tid >> 6);
    const int gw = blockIdx.x * NWAVES + wave, NGW = gridDim.x * NWAVES;
    unsigned char* ws = ka->ws;
    const float* peer_u = (const float*)ka->in[17]; const float* peer_v = (const float*)ka->in[18];
    unsigned char* U8 = ws + WS_U; unsigned char* V8 = ws + WS_V; float* usc = (float*)(ws + WS_USC); float* vsc = (float*)(ws + WS_VSC);
    LAS unsigned char* buf = lds + wave * 16896;
#define CONV_SRC(m) ((const unsigned char*)((m) < NEXP ? peer_u + (size_t)(m) * DM : peer_v + (size_t)((m) - NEXP) * DM) + lane * 16)
    if (m_lo + gw < m_hi) P11_DMA(CONV_SRC(m_lo + gw), buf, 16);
#pragma unroll 1
    for (int m = m_lo + gw; m < m_hi; m += NGW) {
        asm volatile("s_waitcnt vmcnt(0)" ::: "memory");
        f32x4 v[16];
#pragma unroll
        for (int i = 0; i < 16; ++i) v[i] = *(const LAS f32x4*)(buf + i * 1024 + lane * 16);
        asm volatile("s_waitcnt lgkmcnt(0)" ::: "memory");
        const int mn = m + NGW;
        if (mn < m_hi) P11_DMA(CONV_SRC(mn), buf, 16);
        if (m < NEXP) row_emit_fp4(v, U8 + (size_t)m * ROW4, usc + m, lane); else row_emit_fp4(v, V8 + (size_t)(m - NEXP) * ROW4, vsc + (m - NEXP), lane);
    }
    asm volatile("s_waitcnt vmcnt(0)" ::: "memory");
#undef CONV_SRC
}
DI void conv_job(LAS unsigned char* lds) {
    const __attribute__((address_space(4))) Args* ka = (const __attribute__((address_space(4))) Args*)__builtin_amdgcn_kernarg_segment_ptr();
    asm volatile("" : "+s"(ka));
    int tid = threadIdx.x; asm volatile("" : "+v"(tid));
    const int lane = tid & 63, wave = __builtin_amdgcn_readfirstlane(tid >> 6);
    const int G = gridDim.x, gw = blockIdx.x * NWAVES + wave, NGW = G * NWAVES;
    unsigned char* ws = ka->ws;
    const float* w_branch_a = (const float*)ka->in[9]; const float* w_branch_b = (const float*)ka->in[10]; const float* w_out = (const float*)ka->in[13]; const float* norm_ffn = (const float*)ka->in[14];
    const float* w_peer_q = (const float*)ka->in[15]; const float* peer_u = (const float*)ka->in[17]; const float* peer_v = (const float*)ka->in[18];
    const float* swa = (const float*)(ws + WS_SWA); const float* swb = (const float*)(ws + WS_SWB); const float* swo = (const float*)(ws + WS_SWO);
    unsigned char* WCQ = ws + WS_WCQ; unsigned char* WOQ = ws + WS_WOQ; bf16* WQT = (bf16*)(ws + WS_WQT);
    unsigned char* U8 = ws + WS_U; unsigned char* V8 = ws + WS_V; float* usc = (float*)(ws + WS_USC); float* vsc = (float*)(ws + WS_VSC);
            const float q_a = 1.0f / swa[0], q_b = 1.0f / swb[0], q_o = 1.0f / swo[0];
    LAS float* scr = (LAS float*)(lds + wave * 16896);
    constexpr int I_A = (2048 / 128) * (DM / 32), I_B = (512 / 128) * (DM / 32), I_O = (DM / 128) * (DM / 32), I_Q = (DM / 128) * (QW / 32);
    for (int it = gw; it < I_A + I_B + I_O + I_Q; it += NGW) {
        int r = it;
        if (r < I_A) { transpose_tile<1>(w_branch_a, DM, WCQ, YCW, 0, 512, nullptr, q_a, scr, r, lane); continue; } r -= I_A;
        if (r < I_B) { transpose_tile<1>(w_branch_b, DM, WCQ, YCW, 0, 0, nullptr, q_b, scr, r, lane); continue; } r -= I_B;
        if (r < I_O) { transpose_tile<1>(w_out, DM, WOQ, DM, 0, 0, nullptr, q_o, scr, r, lane); continue; } r -= I_O;
        transpose_tile<0>(w_peer_q, QW, (unsigned char*)WQT, DM * 2, 0, 0, norm_ffn, 1.0f, scr, r, lane);
    }
    const int n_light = ((SEQ / 256) * (INW / 256)) % G ? G - ((SEQ / 256) * (INW / 256)) % G : 0, TBL_LATE = n_light * NWAVES * LATE_ROWS;
    conv_rows(lds, NEXP < 2 * NEXP - TBL_LATE ? NEXP : 2 * NEXP - TBL_LATE, 2 * NEXP - TBL_LATE);
}
__global__ void __launch_bounds__(NTHREADS, 2) fwd(Args args) {
    extern __shared__ __attribute__((aligned(16))) unsigned char lds_raw[];
    LAS unsigned char* lds = (LAS unsigned char*)lds_raw;
    volatile LAS unsigned* MISC = (volatile LAS unsigned*)(lds + MISC_OFF);
    const int tid = threadIdx.x, lane = tid & 63, wave = __builtin_amdgcn_readfirstlane(tid >> 6);
    const int G = gridDim.x, bid = blockIdx.x;
    const int gw = bid * NWAVES + wave, NGW = G * NWAVES;
    unsigned char* ws = args.ws;
    const float* x = (const float*)args.in[0]; const int* positions = (const int*)args.in[1]; const float* norm_mix = (const float*)args.in[2];
    const float* w_in = (const float*)args.in[3]; const float* q_norm_a = (const float*)args.in[4]; const float* k_norm_a = (const float*)args.in[5];
    const float* sinks_a = (const float*)args.in[6]; const float* q_norm_b = (const float*)args.in[7]; const float* k_norm_b = (const float*)args.in[8];
    const float* w_branch_a = (const float*)args.in[9]; const float* w_branch_b = (const float*)args.in[10]; const float* w_gate = (const float*)args.in[11];
    const float* b_gate = (const float*)args.in[12]; const float* w_out = (const float*)args.in[13]; const float* norm_ffn = (const float*)args.in[14];
    const float* w_peer_q = (const float*)args.in[15]; const float* sub_keys = (const float*)args.in[16]; const float* peer_u = (const float*)args.in[17];
    const float* peer_v = (const float*)args.in[18];
    float* out = args.out;
    float* rowf1 = (float*)(ws + WS_ROWF1); float* inv2 = (float*)(ws + WS_INV2); float* lse = (float*)(ws + WS_LSE);
    bf16* skb = (bf16*)(ws + WS_SK); float* ropec = (float*)(ws + WS_ROPE); float* ropes = (float*)(ws + WS_ROPE + 512 * 1024);
    int* experts = (int*)(ws + WS_PE); float* pgates = (float*)(ws + WS_PG);
    float* sw1 = (float*)(ws + WS_SW1); float* swa = (float*)(ws + WS_SWA); float* swb = (float*)(ws + WS_SWB); float* swo = (float*)(ws + WS_SWO);
    unsigned char* W1Q = ws + WS_W1Q; unsigned char* WCQ = ws + WS_WCQ; unsigned char* WOQ = ws + WS_WOQ; bf16* WQT = (bf16*)(ws + WS_WQT);
    unsigned char* XQ4 = ws + WS_XQ4; unsigned char* WG4 = ws + WS_WG4; float* rowf4 = (float*)(ws + WS_ROWF4);
    unsigned char* XQ = ws + WS_XQ; bf16* XB = (bf16*)(ws + WS_XB); bf16* PROJ = (bf16*)(ws + WS_PROJ); unsigned char* MERGED = ws + WS_MERGED;
    unsigned char* GATES = ws + WS_GATES; bf16* QB = (bf16*)(ws + WS_Q); unsigned char* YCAT = ws + WS_YCAT; bf16* OG = (bf16*)(ws + WS_OG);
    float* rowpart = (float*)(ws + WS_ROWPART);
    unsigned char* U8 = ws + WS_U; unsigned char* V8 = ws + WS_V; float* usc = (float*)(ws + WS_USC); float* vsc = (float*)(ws + WS_VSC);

    if (tid < 64) MISC[tid] = 0u;
    __syncthreads();
    XcdBarrier bar = xcd_barrier_post((unsigned*)(ws + WS_CTL) + CW_BAR, MISC + 8);
    const int lo = args.ph_lo, hi = args.ph_hi;
#ifndef ONLY_PHASE
#define ONLY_PHASE -1
#endif
#define IN(k) ((ONLY_PHASE < 0 || ONLY_PHASE == (k)) && lo <= (k) && (k) < hi)
#ifndef REP_PHASE
#define REP_PHASE -1
#endif
#define REPS(k) ((REP_PHASE == (k)) ? 2 : 1)
#define SEAM(k) do { if ((k) + 1 < hi || REPS(k) > 1) xcd_barrier(bar); } while (0)

    if (IN(0)) for (int rep_ = 0; rep_ < REPS(0); ++rep_) {
#ifndef P0X
#define P0X 1
#define P0W 1
#define P0T 1
#endif
        for (int rx = 0; rx < P0X; ++rx)
        for (int m = gw; m < SEQ; m += NGW) xrow_to_fp8(x + (size_t)m * DM, XQ + (size_t)m * DM, rowf1 + m, XQ4 + (size_t)m * (DM / 2), rowf4 + m, lane);
        {
            LAS float* red = (LAS float*)(lds + 8 * 16896);
            float rms_g, m_in, m_g0, m_a, m_b, m_o; wg_sample_all(w_in, w_gate, w_branch_a, w_branch_b, w_out, norm_mix, red, m_in, m_g0, rms_g, m_a, m_b, m_o);
            const float m_g = fminf(m_g0, 3.0f * rms_g) * (128.0f / 6.0f);
            const float q_in = m_in > 0.f ? 128.0f / m_in : 1.0f, q_g = m_g > 0.f ? 128.0f / m_g : 1.0f, q_a = m_a > 0.f ? 128.0f / m_a : 1.0f, q_b = m_b > 0.f ? 128.0f / m_b : 1.0f, q_o = m_o > 0.f ? 128.0f / m_o : 1.0f;
            for (int n = bid * NTHREADS + tid; n < N1 + 3 * DM; n += G * NTHREADS) {
                if (n < INW) sw1[n] = 1.0f / q_in; else if (n < N1) sw1[n] = 1.0f / q_g;
                else if (n < N1 + DM) swa[n - N1] = 1.0f / q_a; else if (n < N1 + 2 * DM) swb[n - N1 - DM] = 1.0f / q_b; else swo[n - N1 - 2 * DM] = 1.0f / q_o;
            }
            LAS float* scr = (LAS float*)(lds + wave * 16896);
            constexpr int I_IN = (DM / 128) * (INW / 32), I_G = (DM / 128) * (GATEW / 32), I_A = (2048 / 128) * (DM / 32), I_B = (512 / 128) * (DM / 32), I_O = (DM / 128) * (DM / 32), I_Q = (DM / 128) * (QW / 32);
            constexpr int NIT = I_IN + I_G + I_A + I_B + I_O + I_Q;
            (void)NIT; (void)q_a; (void)q_b; (void)q_o;
            for (int rw = 0; rw < P0W; ++rw)
            for (int it = gw; it < I_IN + I_G; it += NGW) {
                int r = it;
                if (r < I_IN) { transpose_tile<1>(w_in, INW, W1Q, DM, 0, 0, norm_mix, q_in, scr, r, lane); continue; } r -= I_IN;
                transpose_tile<2>(w_gate, GATEW, WG4, DM / 2, 0, 0, norm_mix, q_g, scr, r, lane);
            }
        }
        const int n_light = ((SEQ / 256) * (INW / 256)) % G ? G - ((SEQ / 256) * (INW / 256)) % G : 0, TBL_LATE = n_light * NWAVES * LATE_ROWS;
        (void)TBL_LATE;
        for (int i = bid * NTHREADS + tid; i < 16 * 128 * 128 / 2; i += G * NTHREADS) { const f32x2 v = *(const f32x2*)(sub_keys + 2 * (size_t)i); ((unsigned*)skb)[i] = pk2(v.x, v.y); }
        if (bid == 0) { float* gtab = (float*)(ws + WS_GTAB); gtab[tid] = tid < 128 ? q_norm_a[tid] : (tid < 256 ? k_norm_a[tid - 128] : (tid < 384 ? q_norm_b[tid - 256] : k_norm_b[tid - 384])); }
        for (int i = bid * NTHREADS + tid; i < SEQ * 16; i += G * NTHREADS) {
            const int t = i >> 4, f = i & 15;
            const float invf = expf(-13.122363377404328f * (float)f / 16.0f);
            const float ang = (float)positions[t] * invf;
            const double rev = (double)ang * 0.15915494309189535; const float fr = (float)(rev - rint(rev));
            ropec[i] = __builtin_amdgcn_cosf(fr); ropes[i] = __builtin_amdgcn_sinf(fr);
        }
        SEAM(0);
    }
    if (IN(1)) for (int rep_ = 0; rep_ < REPS(1); ++rep_) {
        {
            pg8::Gemm g{(const bf16*)XQ, (const bf16*)W1Q, SEQ, INW, DM / 2, DM / 2, DM / 2}; pg8::StaticOrder S; S.init(SEQ, INW, G, bid);
            EpiP1 E{ws, (LAS float*)(lds + 131072 + 1024)};
            pg8::gemm_phase<EpiP1, pg8::StaticOrder, true, true, 1>(lds, g, S, E);
        }
        {
            pg8::Gemm g{(const bf16*)XQ4, (const bf16*)WG4, SEQ, GATEW, DM / 4, DM / 4, DM / 4}; pg8::StaticOrder S; S.init(SEQ, GATEW, G, bid);
            EpiG4 E{ws, b_gate};
            pg8::gemm_phase<EpiG4, pg8::StaticOrder, true, true, 2>(lds, g, S, E);
        }
        {
            const int n_heavy = ((SEQ / 256) * (INW / 256)) % G, n_light = n_heavy ? G - n_heavy : 0, TBL_LATE = n_light * NWAVES * LATE_ROWS;
            if (n_light && bid >= n_heavy) {
                const int lw = (bid - n_heavy) * NWAVES + wave;
#pragma unroll 1
                for (int j = 0; j < LATE_ROWS; ++j) { const int m = 2 * NEXP - TBL_LATE + j * (n_light * NWAVES) + lw;
                    if (m < NEXP) row_to_fp4(peer_u + (size_t)m * DM, U8 + (size_t)m * ROW4, usc + m, lane);
                    else row_to_fp4(peer_v + (size_t)(m - NEXP) * DM, V8 + (size_t)(m - NEXP) * ROW4, vsc + (m - NEXP), lane); }
            }
        }
        SEAM(1);
    }
    if (IN(2)) for (int rep_ = 0; rep_ < REPS(2); ++rep_) {
        const bool conv_first = ((bid >> 3) & 1) == 0;
        if (conv_first) { conv_job(lds); __syncthreads(); }
        attention_phase(lds, PROJ, sinks_a, YCAT, OG, lse, bid, G);
        if (!conv_first) { __syncthreads(); conv_job(lds); }
        SEAM(2);
    }
    if (IN(3)) for (int rep_ = 0; rep_ < REPS(3); ++rep_) { combine_phase(OG, lse, YCAT, bid * NTHREADS + tid, G * NTHREADS); SEAM(3); }
    if (IN(4)) for (int rep_ = 0; rep_ < REPS(4); ++rep_) {
        pg8::Gemm g{(const bf16*)YCAT, (const bf16*)WCQ, SEQ, DM, YCW / 2, YCW / 2, YCW / 2}; pg8::StaticOrder S; S.init(SEQ, DM, G, bid);
        EpiMerge E{GATES, MERGED, swa, swb};
        pg8::gemm_phase<EpiMerge, pg8::StaticOrder, true, true, true>(lds, g, S, E);
        SEAM(4);
    }
    if (IN(5)) for (int rep_ = 0; rep_ < REPS(5); ++rep_) {
        const bool rows_first = ((bid >> 3) & 1) != 0;
        if (rows_first) { conv_rows(lds, 0, NEXP); __syncthreads(); }
        pg8::Gemm g{(const bf16*)MERGED, (const bf16*)WOQ, SEQ, DM, DM / 2, DM / 2, DM / 2}; pg8::StaticOrder S; S.init(SEQ, DM, G, bid);
        EpiOut E{x, out, swo, XB, rowpart};
        pg8::gemm_phase<EpiOut, pg8::StaticOrder, true, true, true>(lds, g, S, E);
        if (!rows_first) { __syncthreads(); conv_rows(lds, 0, NEXP); }
        SEAM(5);
    }
    if (IN(6)) for (int rep_ = 0; rep_ < REPS(6); ++rep_) {
        pg8::Gemm g{XB, WQT, SEQ, QW, DM, DM, DM}; pg8::StaticOrder S; S.init(SEQ, QW, G, bid);
        LAS float* inv2l = (LAS float*)(lds + 131072);
        pg8::Unit u0;
        if (S.next(0, u0)) {
            const int rl = tid >> 1, hf = tid & 1; const float* rp = rowpart + (size_t)(u0.pm * 256 + rl) * 64 + hf * 32;
            float s = 0.f;
#pragma unroll
            for (int j = 0; j < 8; ++j) { const f32x4 v = *(const f32x4*)(rp + 4 * j); s += (v.x + v.y) + (v.z + v.w); }
            s += __shfl_xor(s, 1);
            const float iv = 1.0f / sqrtf(s * (1.0f / DM) + EPS);
            if (hf == 0) { inv2l[rl] = iv; if (u0.pn == 0) inv2[u0.pm * 256 + rl] = iv; }
        }
        __syncthreads();
        EpiQ E{QB, inv2l};
        pg8::gemm_phase<EpiQ, pg8::StaticOrder, true, true, false>(lds, g, S, E);
        SEAM(6);
    }
    if (IN(7)) for (int rep_ = 0; rep_ < REPS(7); ++rep_) {
        for (int tb = bid; tb < SEQ / 32; tb += G) {
            routing_block(lds, QB, skb, experts, pgates, tb);
            asm volatile("s_waitcnt vmcnt(0)" ::: "memory");
            __syncthreads();
#pragma unroll 1
            for (int j = 0; j < 4; ++j) { const int t = tb * 32 + wave * 4 + j;
                peer_token(lds + wave * (4 * RSLOT), XB + (size_t)t * DM, inv2[t], norm_ffn, experts + (size_t)t * 128, pgates + (size_t)t * 128, U8, V8, usc, vsc, out + (size_t)t * DM, lane); }
            __syncthreads();
        }
    }
#undef IN
#undef SEAM
}

extern "C" void kernel_launch(void* const* d_in, const int* in_sizes, int n_in, void* d_out, int out_size, void* d_ws, size_t ws_size, hipStream_t stream) {
    static int grid = 0;
    if (grid == 0) {
        if (n_in != 19 || out_size != SEQ * DM || ws_size < WS_END) { fprintf(stderr, "kernel_launch: unexpected shapes (n_in %d, out %d, ws %zu); nothing launched\n", n_in, out_size, ws_size); grid = -1; return; }
        int dev = 0, cus = 0, per_cu = 0;
        if (hipGetDevice(&dev) != hipSuccess || hipDeviceGetAttribute(&cus, hipDeviceAttributeMultiprocessorCount, dev) != hipSuccess) { grid = -1; return; }
        if (hipFuncSetAttribute((const void*)fwd, hipFuncAttributeMaxDynamicSharedMemorySize, LDS_BYTES) != hipSuccess) { fprintf(stderr, "kernel_launch: hipFuncSetAttribute failed\n"); grid = -1; return; }
        if (hipOccupancyMaxActiveBlocksPerMultiprocessor(&per_cu, (const void*)fwd, NTHREADS, LDS_BYTES) != hipSuccess || per_cu < 1) { fprintf(stderr, "kernel_launch: occupancy query says %d\n", per_cu); (void)hipGetLastError(); grid = -1; return; }
        grid = cus;
    }
    if (grid < 0) return;
    (void)hipMemsetAsync((char*)d_ws + WS_CTL, 0, CTL_ZERO_BYTES, stream);
    Args a{};
    for (int i = 0; i < 19; ++i) a.in[i] = d_in[i];
    a.out = (float*)d_out; a.ws = (unsigned char*)d_ws;
#if MK_N_LAUNCHES == 1
    a.ph_lo = 0; a.ph_hi = NPHASES;
    hipLaunchKernelGGL(fwd, dim3(grid), dim3(NTHREADS), LDS_BYTES, stream, a);
#else
#ifndef TWICE_PHASE
#define TWICE_PHASE -1
#endif
    for (int p = 0; p < NPHASES; ++p) { a.ph_lo = p; a.ph_hi = p + 1; hipLaunchKernelGGL(fwd, dim3(grid), dim3(NTHREADS), LDS_BYTES, stream, a);
        if (p == TWICE_PHASE) hipLaunchKernelGGL(fwd, dim3(grid), dim3(NTHREADS), LDS_BYTES, stream, a);
        if (TWICE_PHASE == 99 && p == NPHASES - 1) { for (int p2 = 0; p2 < NPHASES; ++p2) { a.ph_lo = p2; a.ph_hi = p2 + 1; hipLaunchKernelGGL(fwd, dim3(grid), dim3(NTHREADS), LDS_BYTES, stream, a); } }
        if (TWICE_PHASE == 23 && p == 3) { a.ph_lo = 2; a.ph_hi = 3; hipLaunchKernelGGL(fwd, dim3(grid), dim3(NTHREADS), LDS_BYTES, stream, a); a.ph_lo = 3; a.ph_hi = 4; hipLaunchKernelGGL(fwd, dim3(grid), dim3(NTHREADS), LDS_BYTES, stream, a); } }
#endif
}
```

```cpp
#include <hip/hip_runtime.h>
#include <cstdio>
#include <cstdint>

#ifndef MK_N_LAUNCHES
#define MK_N_LAUNCHES 1
#endif

namespace pg8 {
#define PG8_LAS __attribute__((address_space(3)))
typedef unsigned short bf16_t;
typedef short bf16x8 __attribute__((ext_vector_type(8)));
typedef float f32x4 __attribute__((ext_vector_type(4)));
typedef unsigned u32x4 __attribute__((ext_vector_type(4)));
typedef int i32x4 __attribute__((ext_vector_type(4)));
typedef int i32x8 __attribute__((ext_vector_type(8)));
constexpr int BM = 256, BK = 64, HALF = 128, HTB = HALF * BK * 2  , STAGE_BYTES = 8 * HTB, NXCD = 8, WGM = 8;

__host__ __device__ __forceinline__ int lds_byte(int r, int c) { const int st = (r >> 4) * 2 + (c >> 5), rr = r & 15, cc = c & 31, ob = rr * 64 + cc * 2; return st * 1024 + (ob ^ (((ob >> 9) & 1) << 5)); }
__host__ __device__ __forceinline__ void stage_rc(int b, int& R, int& C) { const int st = b / 1024, sb = b % 1024, swz = sb ^ (((sb >> 9) & 1) << 5); R = (st >> 1) * 16 + swz / 64; C = (st & 1) * 32 + (swz % 64) / 2; }
__host__ __device__ __forceinline__ int perm32(int rho) { const int n = rho >> 4, i = rho & 15; return 8 * (i >> 2) + 4 * n + (i & 3); }

struct Unit { int pm, pn; };
struct Gemm { const bf16_t* A; const bf16_t* Bt; int M, N, K, lda, ldb; };

struct StaticOrder {
    int nM, nN, nwg, G, c;
    __host__ __device__ void init(int M, int N, int G_, int c_) { nM = M / BM; nN = N / BM; nwg = nM * nN; G = G_; c = c_; }
    __host__ __device__ bool next(int i, Unit& u) const {
        const long L = (long)i * G + c; if (L >= nwg) return false;
        int wgid = (int)L; { const int q = nwg / NXCD, r = nwg % NXCD, xcd = wgid % NXCD, off = wgid / NXCD; wgid = (xcd < r ? xcd * (q + 1) : r * (q + 1) + (xcd - r) * q) + off; }
        const int nig = WGM * nN, gid = wgid / nig, fm = gid * WGM, gsz = (nM - fm) < WGM ? (nM - fm) : WGM;
        u.pm = fm + ((wgid % nig) % gsz); u.pn = (wgid % nig) / gsz; return true;
    }
    __device__ __forceinline__ void a_ready(const Unit&) const {}
    __device__ __forceinline__ void done(const Unit&) const {}
};

__device__ __forceinline__ unsigned cvt_pk_bf16(float lo, float hi) { unsigned r; asm volatile("v_cvt_pk_bf16_f32 %0, %1, %2" : "=v"(r) : "v"(lo), "v"(hi)); return r; }

template <class Epi, class Sched, bool ALIGN_EPI = false, bool SP2 = false, int FP8 = 0  >
__device__ __forceinline__ void gemm_phase(PG8_LAS unsigned char* lds, const Gemm g, const Sched& S, const Epi& E) {
    const int tid = threadIdx.x, wid = __builtin_amdgcn_readfirstlane(tid >> 6), lane = tid & 63, wr = wid >> 2, wc = wid & 3, fr = lane & 15, fq = lane >> 4;
    const int K = g.K, nt = K / BK;
    unsigned voffA[2], voffB[2];
#pragma unroll
    for (int i = 0; i < 2; ++i) { int R, C; stage_rc(tid * 16 + i * 8192, R, C); const int Rb = Epi::PERM ? ((R & ~31) + perm32(R & 31)) : R;
        voffA[i] = (unsigned)(R * g.lda + C) * 2u; voffB[i] = (unsigned)(Rb * g.ldb + C) * 2u; }
    const size_t kstep = (size_t)(BK * 2);
    const size_t hstepA = (size_t)HALF * g.lda * 2, hstepB = (size_t)HALF * g.ldb * 2;
    const size_t tstepA = 2 * hstepA, tstepB = 2 * hstepB;
    const unsigned ldsw = (unsigned)wid * 1024u;
    const int aoff = lds_byte(wr * 64 + fr, fq * 8), boff = lds_byte(wc * 32 + fr, fq * 8);
#define PG8_SA(b, h) (((b) * 2 + (h)) * HTB)
#define PG8_SB(b, h) ((4 + (b) * 2 + (h)) * HTB)
#define PG8_STAGE(bufoff, gbase, voff) do { _Pragma("unroll") for (int _i = 0; _i < 2; ++_i) \
        __builtin_amdgcn_global_load_lds((const unsigned*)((const char*)(gbase) + (voff)[_i]), (PG8_LAS unsigned*)(lds + (bufoff) + ldsw + _i * 8192), 16, 0, 0); } while (0)
#define PG8_LDA(dst, b, h) do { _Pragma("unroll") for (int m = 0; m < 4; ++m) _Pragma("unroll") for (int k = 0; k < 2; ++k) dst[m][k] = *(const PG8_LAS bf16x8*)(lds + PG8_SA(b, h) + aoff + m * 2048 + k * 1024); } while (0)
#define PG8_LDB(dst, b, h) do { _Pragma("unroll") for (int n = 0; n < 2; ++n) _Pragma("unroll") for (int k = 0; k < 2; ++k) dst[n][k] = *(const PG8_LAS bf16x8*)(lds + PG8_SB(b, h) + boff + n * 2048 + k * 1024); } while (0)
#define PG8_CAT(x0, x1) __builtin_shufflevector(__builtin_bit_cast(i32x4, x0), __builtin_bit_cast(i32x4, x1), 0, 1, 2, 3, 4, 5, 6, 7)
#define PG8_MMA(ai, bj, At, Bt) do { __builtin_amdgcn_s_setprio(1); \
        if constexpr (FP8 == 2) { _Pragma("unroll") for (int m = 0; m < 4; ++m) _Pragma("unroll") for (int n = 0; n < 2; ++n) _Pragma("unroll") for (int k = 0; k < 2; ++k) \
            asm volatile("v_mfma_scale_f32_16x16x128_f8f6f4 %0, %1, %2, %0, %3, %3 op_sel_hi:[0,0,0] cbsz:4 blgp:4" : "+v"(acc[ai][bj][m][n]) : "v"(__builtin_bit_cast(i32x4, Bt[n][k])), "v"(__builtin_bit_cast(i32x4, At[m][k])), "v"(one_scale)); } \
        else if constexpr (FP8 == 1) { _Pragma("unroll") for (int m = 0; m < 4; ++m) _Pragma("unroll") for (int n = 0; n < 2; ++n) \
            asm volatile("v_mfma_scale_f32_16x16x128_f8f6f4 %0, %1, %2, %0, %3, %3 op_sel_hi:[0,0,0]" : "+v"(acc[ai][bj][m][n]) : "v"(PG8_CAT(Bt[n][0], Bt[n][1])), "v"(PG8_CAT(At[m][0], At[m][1])), "v"(one_scale)); } \
        else { _Pragma("unroll") for (int m = 0; m < 4; ++m) _Pragma("unroll") for (int n = 0; n < 2; ++n) _Pragma("unroll") for (int k = 0; k < 2; ++k) \
            acc[ai][bj][m][n] = __builtin_amdgcn_mfma_f32_16x16x32_bf16(Bt[n][k], At[m][k], acc[ai][bj][m][n], 0, 0, 0); } \
        __builtin_amdgcn_s_setprio(0); } while (0)
#define PG8_WAIT_V(n) asm volatile("s_waitcnt vmcnt(" #n ")" ::: "memory")
#define PG8_WAIT_L(n) asm volatile("s_waitcnt lgkmcnt(" #n ")" ::: "memory")
#define PG8_BAR __builtin_amdgcn_s_barrier()
#define PG8_SCHED __builtin_amdgcn_sched_barrier(0)
    Unit cur, nxt; int ui = 0;
    if (!S.next(0, cur)) return;
    const int one_scale = 0x7F7F7F7F;
    f32x4 acc[2][2][4][2];
#pragma unroll
    for (int a = 0; a < 2; ++a)
#pragma unroll
        for (int b = 0; b < 2; ++b)
#pragma unroll
            for (int m = 0; m < 4; ++m)
#pragma unroll
                for (int n = 0; n < 2; ++n) acc[a][b][m][n] = (f32x4){0.f, 0.f, 0.f, 0.f};
    bf16x8 At[4][2], B0[2][2], B1[2][2];
    const char* cA = (const char*)g.A + (size_t)cur.pm * tstepA; const char* cB = (const char*)g.Bt + (size_t)cur.pn * tstepB;
    S.a_ready(cur);
    if constexpr (SP2) {
        PG8_STAGE(PG8_SB(0, 0), cB, voffB); PG8_STAGE(PG8_SB(0, 1), cB + hstepB, voffB); PG8_STAGE(PG8_SA(0, 0), cA, voffA); PG8_STAGE(PG8_SA(0, 1), cA + hstepA, voffA);
        if (wr == 1) PG8_BAR;
        PG8_WAIT_V(2); PG8_BAR;
        PG8_STAGE(PG8_SB(1, 0), cB + kstep, voffB); PG8_STAGE(PG8_SA(1, 0), cA + kstep, voffA); PG8_STAGE(PG8_SB(1, 1), cB + hstepB + kstep, voffB);
        PG8_WAIT_V(6); PG8_BAR;
    } else {
        PG8_STAGE(PG8_SB(0, 0), cB, voffB); PG8_STAGE(PG8_SA(0, 0), cA, voffA); PG8_STAGE(PG8_SB(0, 1), cB + hstepB, voffB); PG8_STAGE(PG8_SA(0, 1), cA + hstepA, voffA);
        if (wr == 1) PG8_BAR;
        PG8_WAIT_V(4); PG8_BAR;
        PG8_STAGE(PG8_SB(1, 0), cB + kstep, voffB); PG8_STAGE(PG8_SA(1, 0), cA + kstep, voffA); PG8_STAGE(PG8_SB(1, 1), cB + hstepB + kstep, voffB);
        PG8_WAIT_V(6); PG8_BAR;
    }
    for (;;) {
        const bool has_next = S.next(ui + 1, nxt);
        const char* nA = has_next ? (const char*)g.A + (size_t)nxt.pm * tstepA : cA; const char* nB = has_next ? (const char*)g.Bt + (size_t)nxt.pn * tstepB : cB;
#pragma unroll 1
        for (int t = 0; t < nt; t += 2) {
            const bool last = (t == nt - 2);
            const char* a1 = cA + (size_t)(t + 1) * kstep;
            const char* a2 = last ? nA : cA + (size_t)(t + 2) * kstep; const char* b2 = last ? nB : cB + (size_t)(t + 2) * kstep;
            const char* a3 = a2 + kstep; const char* b3 = b2 + kstep;
            if (last && has_next) S.a_ready(nxt);
            if constexpr (Epi::MIDK > 0) { if (t == Epi::MIDK) {
                if constexpr (FP8) asm volatile("s_nop 15\n\ts_nop 15" ::: "memory");
                E.mid(acc, cur, wr, wc, fr, fq);
                if constexpr (FP8) asm volatile("s_nop 7" ::: "memory"); } }
            if constexpr (SP2) {
            PG8_LDB(B0, 0, 0); PG8_LDB(B1, 0, 1); PG8_SCHED; PG8_LDA(At, 0, 0); PG8_STAGE(PG8_SA(1, 1), a1 + hstepA, voffA);
            PG8_WAIT_V(8); PG8_WAIT_L(0); PG8_BAR; PG8_MMA(0, 0, At, B0); PG8_MMA(0, 1, At, B1); PG8_BAR; PG8_SCHED;
            PG8_LDA(At, 0, 1); PG8_STAGE(PG8_SB(0, 0), b2, voffB); PG8_STAGE(PG8_SB(0, 1), b2 + hstepB, voffB); PG8_STAGE(PG8_SA(0, 0), a2, voffA);
            PG8_WAIT_V(8); PG8_WAIT_L(0); PG8_BAR; PG8_MMA(1, 0, At, B0); PG8_MMA(1, 1, At, B1); PG8_BAR; PG8_SCHED;
            PG8_LDB(B0, 1, 0); PG8_LDB(B1, 1, 1); PG8_SCHED; PG8_LDA(At, 1, 0); PG8_STAGE(PG8_SA(0, 1), a2 + hstepA, voffA);
            PG8_WAIT_V(8); PG8_WAIT_L(0); PG8_BAR; PG8_MMA(0, 0, At, B0); PG8_MMA(0, 1, At, B1); PG8_BAR; PG8_SCHED;
            PG8_LDA(At, 1, 1); PG8_STAGE(PG8_SB(1, 0), b3, voffB); PG8_STAGE(PG8_SB(1, 1), b3 + hstepB, voffB); PG8_STAGE(PG8_SA(1, 0), a3, voffA);
            PG8_WAIT_V(8); PG8_WAIT_L(0); PG8_BAR; PG8_MMA(1, 0, At, B0); PG8_MMA(1, 1, At, B1); PG8_BAR; PG8_SCHED;
            } else {
            PG8_LDB(B0, 0, 0); PG8_SCHED; PG8_LDA(At, 0, 0); PG8_STAGE(PG8_SA(1, 1), a1 + hstepA, voffA);
            PG8_WAIT_L(8); PG8_BAR; PG8_WAIT_L(0); PG8_MMA(0, 0, At, B0); PG8_BAR; PG8_SCHED;
            PG8_LDB(B1, 0, 1); PG8_STAGE(PG8_SB(0, 0), b2, voffB);
            PG8_BAR; PG8_WAIT_L(0); PG8_MMA(0, 1, At, B1); PG8_BAR;
            PG8_LDA(At, 0, 1); PG8_STAGE(PG8_SA(0, 0), a2, voffA);
            PG8_BAR; PG8_WAIT_L(0); PG8_MMA(1, 0, At, B0); PG8_BAR; PG8_SCHED;
            PG8_STAGE(PG8_SB(0, 1), b2 + hstepB, voffB);
            PG8_WAIT_V(6); PG8_BAR; PG8_MMA(1, 1, At, B1); PG8_BAR;
            PG8_LDB(B0, 1, 0); PG8_SCHED; PG8_LDA(At, 1, 0); PG8_STAGE(PG8_SA(0, 1), a2 + hstepA, voffA);
            PG8_WAIT_L(8); PG8_BAR; PG8_WAIT_L(0); PG8_MMA(0, 0, At, B0); PG8_BAR; PG8_SCHED;
            PG8_LDB(B1, 1, 1); PG8_STAGE(PG8_SB(1, 0), b3, voffB);
            PG8_BAR; PG8_WAIT_L(0); PG8_MMA(0, 1, At, B1); PG8_BAR;
            PG8_LDA(At, 1, 1); PG8_STAGE(PG8_SA(1, 0), a3, voffA);
            PG8_BAR; PG8_WAIT_L(0); PG8_MMA(1, 0, At, B0); PG8_BAR; PG8_SCHED;
            PG8_STAGE(PG8_SB(1, 1), b3 + hstepB, voffB);
            PG8_WAIT_V(6); PG8_BAR; PG8_MMA(1, 1, At, B1); PG8_BAR;
            }
        }
        if constexpr (ALIGN_EPI) { if (wr == 0) PG8_BAR; }
        if constexpr (FP8) asm volatile("s_nop 15\n\ts_nop 15" ::: "memory");
        E(acc, cur, wr, wc, fr, fq); S.done(cur);
        if (!has_next) break;
#pragma unroll
        for (int a = 0; a < 2; ++a)
#pragma unroll
            for (int b = 0; b < 2; ++b)
#pragma unroll
                for (int m = 0; m < 4; ++m)
#pragma unroll
                    for (int n = 0; n < 2; ++n) acc[a][b][m][n] = (f32x4){0.f, 0.f, 0.f, 0.f};
        cur = nxt; cA = nA; cB = nB; ++ui;
        if constexpr (ALIGN_EPI) { if (wr == 1) PG8_BAR; }
    }
    PG8_WAIT_V(0);
    if constexpr (!ALIGN_EPI) { if (wr == 0) PG8_BAR; }
    PG8_BAR;
#undef PG8_SA
#undef PG8_SB
#undef PG8_STAGE
#undef PG8_LDA
#undef PG8_LDB
#undef PG8_MMA
#undef PG8_CAT
#undef PG8_WAIT_V
#undef PG8_WAIT_L
#undef PG8_BAR
#undef PG8_SCHED
}
}

constexpr int SEQ = 8192, DM = 4096, HD = 128;
constexpr int INW = 7680, GATEW = 8192, N1 = INW + GATEW;
constexpr int YCW = 2560;
constexpr int QW = 2048;
constexpr int NEXP = 16384;
constexpr int COL_QA = 0, COL_KA = 2048, COL_VA = 2560, COL_QB = 3072, COL_KB = 4608, COL_VB = 6144;
constexpr float EPS = 1e-6f;
constexpr int NWAVES = 8, NTHREADS = 512;
constexpr int NPHASES = 8;

constexpr size_t MiB = 1u << 20;
constexpr size_t WS_CTL = 0, CTL_ZERO_BYTES = 64 * 1024;
constexpr size_t WS_INV1 = 1 * MiB, WS_INV2 = 1 * MiB + 64 * 1024, WS_LSE = 1 * MiB + 128 * 1024;
constexpr size_t WS_SK = 1 * MiB + 512 * 1024;
constexpr size_t WS_ROPE = 2 * MiB;
constexpr size_t WS_PE = 4 * MiB, WS_PG = 8 * MiB;
constexpr size_t WS_ROWF1 = 1 * MiB;
constexpr size_t WS_SW1 = 12 * MiB + 128 * 1024;
constexpr size_t WS_SWA = 12 * MiB + 192 * 1024, WS_SWB = 12 * MiB + 208 * 1024, WS_SWO = 12 * MiB + 224 * 1024;
constexpr size_t WS_W1Q = 16 * MiB;
constexpr size_t WS_WCQ = 80 * MiB;
constexpr size_t WS_WOQ = 92 * MiB;
constexpr size_t WS_WQT = 108 * MiB;
constexpr size_t WS_XQ = 124 * MiB;
constexpr size_t WS_XB = 156 * MiB;
constexpr size_t WS_PROJ = 220 * MiB;
constexpr size_t WS_MERGED = 220 * MiB;
constexpr size_t WS_GATES = 340 * MiB;
constexpr size_t WS_Q = 340 * MiB;
constexpr size_t WS_YCAT = 468 * MiB;
constexpr size_t WS_OG = 488 * MiB;
constexpr size_t WS_U = 512 * MiB, WS_V = 576 * MiB;
constexpr size_t WS_USC = 12 * MiB, WS_VSC = 12 * MiB + 64 * 1024;
constexpr size_t WS_XQ4 = 640 * MiB;
constexpr size_t WS_WG4 = 656 * MiB;
constexpr size_t WS_GTAB = 12 * MiB + 256 * 1024;
constexpr size_t WS_ROWF4 = 12 * MiB + 320 * 1024;
constexpr size_t WS_ROWPART = 13 * MiB;
constexpr size_t WS_END = 672 * MiB;
constexpr float YSCALE = 64.0f, MSCALE = 128.0f;

constexpr int CW_BAR = 4096;
constexpr int LDS_BYTES = 147456;
constexpr int MISC_OFF = 147456 - 256;

#define GAS __attribute__((address_space(1)))
#define LAS __attribute__((address_space(3)))
typedef unsigned short bf16;
typedef unsigned v4u __attribute__((ext_vector_type(4)));
typedef unsigned v2u __attribute__((ext_vector_type(2)));
typedef float f32x4 __attribute__((ext_vector_type(4)));
typedef float f32x2 __attribute__((ext_vector_type(2)));
typedef float f32x16 __attribute__((ext_vector_type(16)));
typedef short bf16x8 __attribute__((ext_vector_type(8)));
typedef short s16x4 __attribute__((ext_vector_type(4)));
typedef __bf16 bfv2 __attribute__((ext_vector_type(2)));
#define DI __device__ __forceinline__

DI unsigned pk2(float lo, float hi) { f32x2 v = {lo, hi}; return __builtin_bit_cast(unsigned, __builtin_convertvector(v, bfv2)); }
DI float bflo(unsigned w) { return __builtin_bit_cast(float, w << 16); }
DI float bfhi(unsigned w) { return __builtin_bit_cast(float, w & 0xffff0000u); }
DI float wave_sum(float v) {
#pragma unroll
    for (int o = 1; o < 64; o <<= 1) v += __shfl_xor(v, o);
    return v;
}

#define XB_TMO      128
#define XB_XCNT(j)  (256  + 64 * (j))
#define XB_XSUB(j)  (1280 + 64 * (j))
#define XB_XGEN(j)  (2304 + 64 * (j))
#define XB_TOP      3328
#define XB_TOPGEN   3392
#define XCD_BAR_WORDS 3456
#define XB_SPIN_CAP (1u << 22)

__device__ __forceinline__ unsigned xb_ld(unsigned* p)              { return __hip_atomic_load(p, __ATOMIC_RELAXED, __HIP_MEMORY_SCOPE_AGENT); }
__device__ __forceinline__ unsigned xb_add(unsigned* p, unsigned v) { return __hip_atomic_fetch_add(p, v, __ATOMIC_RELAXED, __HIP_MEMORY_SCOPE_AGENT); }
__device__ __forceinline__ unsigned xb_xcc_id() { return (unsigned)__builtin_amdgcn_s_getreg((3 << 11) | 20) & 0xFu; }
#define XB_SPIN(cond, bar) do { unsigned _sp = 0; while (cond) { __builtin_amdgcn_s_sleep(1); \
    if ((++_sp & 255u) == 0u) { if (xb_ld(&(bar)[XB_TMO])) break; if (_sp > XB_SPIN_CAP) { atomicAdd(&(bar)[XB_TMO], 1u); break; } } } } while (0)

struct XcdBarrier { unsigned* bar; unsigned x; volatile LAS unsigned* st; };

__device__ __forceinline__ XcdBarrier xcd_barrier_post(unsigned* bar, volatile LAS unsigned* st) {
    XcdBarrier b; b.bar = bar; b.x = xb_xcc_id(); b.st = st;
    if (threadIdx.x == 0) (void)xb_add(&bar[XB_XCNT(b.x)], 1u);
    return b;
}
__device__ __forceinline__ void xcd_barrier_complete(unsigned* bar, unsigned x, unsigned& nloc, unsigned& nx) {
    const unsigned G = gridDim.x * gridDim.y * gridDim.z;
    unsigned sum, cnt, mine, sp = 0u;
    for (;;) {
        sum = 0u; cnt = 0u; mine = 0u;
#pragma unroll
        for (unsigned j = 0; j < 16; ++j) { const unsigned c = xb_ld(&bar[XB_XCNT(j)]); sum += c; cnt += (c > 0u) ? 1u : 0u; mine = (j == x) ? c : mine; }
        if (sum == G) break;
        __builtin_amdgcn_s_sleep(1);
        if ((++sp & 255u) == 0u) { if (xb_ld(&bar[XB_TMO])) break; if (sp > XB_SPIN_CAP) { atomicAdd(&bar[XB_TMO], 1u); break; } }
    }
    nloc = mine > 0u ? mine : 1u; nx = cnt > 0u ? cnt : 1u;
}
__device__ __forceinline__ void xcd_barrier(const XcdBarrier& b) {
    asm volatile("s_waitcnt vmcnt(0)" ::: "memory");
    __syncthreads();
    if (threadIdx.x == 0) {
        unsigned* bar = b.bar;
        __builtin_amdgcn_s_waitcnt(0);
        unsigned nloc = b.st[0], nx = b.st[1];
        if (nloc == 0u) { xcd_barrier_complete(bar, b.x, nloc, nx); b.st[0] = nloc; b.st[1] = nx; }
        const unsigned old = xb_add(&bar[XB_XSUB(b.x)], 1u);
        const unsigned gen = old / nloc;
        if (old + 1u == (gen + 1u) * nloc) {
            __builtin_amdgcn_fence(__ATOMIC_RELEASE, "agent");
            asm volatile("s_waitcnt vmcnt(0)" ::: "memory");
            const unsigned og = xb_add(&bar[XB_TOP], 1u);
            const unsigned tg = og / nx;
            if (og + 1u == (tg + 1u) * nx) xb_add(&bar[XB_TOPGEN], 1u);
            else XB_SPIN(xb_ld(&bar[XB_TOPGEN]) == tg, bar);
            __builtin_amdgcn_fence(__ATOMIC_ACQUIRE, "agent");
            xb_add(&bar[XB_XGEN(b.x)], 1u);
            asm volatile("s_waitcnt vmcnt(0)" ::: "memory");
        } else {
            XB_SPIN(xb_ld(&bar[XB_XGEN(b.x)]) == gen, bar);
            __builtin_amdgcn_fence(__ATOMIC_ACQUIRE, "agent");
            asm volatile("s_waitcnt vmcnt(0)" ::: "memory");
        }
    }
    __syncthreads();
}

DI void unp8_fp8(v2u w, float (&f)[8]) {
    const f32x2 a = __builtin_amdgcn_cvt_pk_f32_fp8((int)w.x, false), b = __builtin_amdgcn_cvt_pk_f32_fp8((int)w.x, true), c = __builtin_amdgcn_cvt_pk_f32_fp8((int)w.y, false), d = __builtin_amdgcn_cvt_pk_f32_fp8((int)w.y, true);
    f[0] = a.x; f[1] = a.y; f[2] = b.x; f[3] = b.y; f[4] = c.x; f[5] = c.y; f[6] = d.x; f[7] = d.y;
}
DI unsigned pk4_fp8(float a, float b, float c, float d) {
    a = fminf(fmaxf(a, -448.f), 448.f); b = fminf(fmaxf(b, -448.f), 448.f); c = fminf(fmaxf(c, -448.f), 448.f); d = fminf(fmaxf(d, -448.f), 448.f);
    int p = __builtin_amdgcn_cvt_pk_fp8_f32(a, b, 0, false); p = __builtin_amdgcn_cvt_pk_fp8_f32(c, d, p, true); return (unsigned)p;
}

struct EpiP1 {
    static constexpr bool PERM = true; static constexpr int MIDK = 0;
    unsigned char* ws; LAS float* red;
    DI void operator()(const pg8::f32x4 (&acc)[2][2][4][2], const pg8::Unit& u, int wr, int wc, int fr, int fq) const {
        asm volatile("" : "+v"(fr), "+v"(fq));
        bf16* proj = (bf16*)(ws + WS_PROJ); unsigned char* gates = ws + WS_GATES; const float* inv1 = (const float*)(ws + WS_ROWF1); const float* sw = (const float*)(ws + WS_SW1);
        const float* ropec = (const float*)(ws + WS_ROPE); const float* ropes = ropec + SEQ * 16; const float* gtab = (const float*)(ws + WS_GTAB);
        const int row0 = u.pm * 256 + wr * 64 + fr, col0 = u.pn * 256 + wc * 32 + 8 * fq;
        const int pn = u.pn;
        const bool normed = (pn < 10) || (pn >= 12 && pn < 24);
        const float* gain = gtab + (pn < 8 ? 0 : (pn < 10 ? 128 : (pn < 18 ? 256 : 384)));
        const float cw = sw[0];
        if (!normed) {
#pragma unroll
            for (int ai = 0; ai < 2; ++ai)
#pragma unroll
                for (int m = 0; m < 4; ++m) {
                    const int row = row0 + ai * 128 + m * 16; const float s = inv1[row] * cw;
#pragma unroll
                    for (int bj = 0; bj < 2; ++bj) {
                        const f32x4 v0 = acc[ai][bj][m][0] * s, v1 = acc[ai][bj][m][1] * s;
                        v4u w; w.x = pk2(v0[0], v0[1]); w.y = pk2(v0[2], v0[3]); w.z = pk2(v1[0], v1[1]); w.w = pk2(v1[2], v1[3]);
                        *(v4u*)(proj + (size_t)row * INW + col0 + bj * 128) = w;
                    }
                }
            return;
        }
#pragma unroll
        for (int ai = 0; ai < 2; ++ai)
#pragma unroll
            for (int m = 0; m < 4; ++m) {
                const int rl = ai * 128 + wr * 64 + m * 16 + fr; const float s = inv1[u.pm * 256 + rl] * cw;
#pragma unroll
                for (int bj = 0; bj < 2; ++bj) {
                    const f32x4 v0 = acc[ai][bj][m][0], v1 = acc[ai][bj][m][1];
                    float ss = ((v0[0] * v0[0] + v0[1] * v0[1]) + (v0[2] * v0[2] + v0[3] * v0[3]) + (v1[0] * v1[0] + v1[1] * v1[1]) + (v1[2] * v1[2] + v1[3] * v1[3])) * (s * s);
                    ss += __shfl_xor(ss, 16); ss += __shfl_xor(ss, 32);
                    if (fq == 0) red[(rl * 2 + bj) * 4 + wc] = ss;
                }
            }
        asm volatile("s_waitcnt lgkmcnt(0)" ::: "memory"); __builtin_amdgcn_s_barrier(); asm volatile("" ::: "memory");
        const f32x4 g0 = *(const f32x4*)(gain + wc * 32 + 8 * fq), g1 = *(const f32x4*)(gain + wc * 32 + 8 * fq + 4);
#pragma unroll
        for (int ai = 0; ai < 2; ++ai)
#pragma unroll
            for (int m = 0; m < 4; ++m) {
                const int rl = ai * 128 + wr * 64 + m * 16 + fr, row = u.pm * 256 + rl; const float s = inv1[row] * cw;
                f32x4 cs0 = {1.f, 1.f, 1.f, 1.f}, cs1 = cs0, sn0 = {0.f, 0.f, 0.f, 0.f}, sn1 = sn0;
                if (wc == 0) { const int ri = row * 16 + (fq & 1) * 8; cs0 = *(const f32x4*)(ropec + ri); cs1 = *(const f32x4*)(ropec + ri + 4); sn0 = *(const f32x4*)(ropes + ri); sn1 = *(const f32x4*)(ropes + ri + 4); }
#pragma unroll
                for (int bj = 0; bj < 2; ++bj) {
                    const LAS float* rp = red + (rl * 2 + bj) * 4;
                    const float inv = 1.0f / sqrtf(((rp[0] + rp[1]) + (rp[2] + rp[3])) * (1.0f / HD) + EPS);
                    const float f = s * inv;
                    f32x4 v0 = acc[ai][bj][m][0] * g0 * f, v1 = acc[ai][bj][m][1] * g1 * f;
                    if (wc == 0) {
                        f32x4 p0, p1;
#pragma unroll
                        for (int j = 0; j < 4; ++j) { p0[j] = __shfl_xor(v0[j], 32); p1[j] = __shfl_xor(v1[j], 32); }
                        const float sg = (fq < 2) ? -1.0f : 1.0f;
                        v0 = v0 * cs0 + p0 * sn0 * sg; v1 = v1 * cs1 + p1 * sn1 * sg;
                    }
                    v4u w; w.x = pk2(v0[0], v0[1]); w.y = pk2(v0[2], v0[3]); w.z = pk2(v1[0], v1[1]); w.w = pk2(v1[2], v1[3]);
                    *(v4u*)(proj + (size_t)row * INW + col0 + bj * 128) = w;
                }
            }
        __builtin_amdgcn_s_barrier();
    }
};
DI void narrow16(v4u w, v2u& ra, v2u& rb) {
    const auto sx = __builtin_amdgcn_permlane16_swap(w.x, w.z, false, false), sy = __builtin_amdgcn_permlane16_swap(w.y, w.w, false, false);
    ra = (v2u){sx[0], sy[0]}; rb = (v2u){sx[1], sy[1]};
}
DI v4u widen16(v2u a, v2u b) {
    const auto rx = __builtin_amdgcn_permlane16_swap(a.x, b.x, false, false), ry = __builtin_amdgcn_permlane16_swap(a.y, b.y, false, false);
    return (v4u){rx[0], ry[0], rx[1], ry[1]};
}
struct EpiG4 {
    static constexpr bool PERM = true; static constexpr int MIDK = 0;
    unsigned char* ws; const float* bgate;
    DI void operator()(const pg8::f32x4 (&acc)[2][2][4][2], const pg8::Unit& u, int wr, int wc, int fr, int fq) const {
        asm volatile("" : "+v"(fr), "+v"(fq));
        unsigned char* gates = ws + WS_GATES; const float* rowf = (const float*)(ws + WS_ROWF4); const float cs = *(const float*)(ws + WS_SW1 + (size_t)INW * 4);
        const int row0 = u.pm * 256 + wr * 64 + fr, col0 = u.pn * 256 + wc * 32 + 8 * fq;
        const int colw = u.pn * 256 + wc * 32 + 8 * (fq & ~1), rsel = fq & 1;
        f32x4 bq[2][2];
#pragma unroll
        for (int bj = 0; bj < 2; ++bj)
#pragma unroll
            for (int n = 0; n < 2; ++n) bq[bj][n] = *(const f32x4*)(bgate + col0 + bj * 128 + 4 * n) * (-1.4426950408889634f) - 8.0f;
#pragma unroll
        for (int ai = 0; ai < 2; ++ai)
#pragma unroll
            for (int mp = 0; mp < 2; ++mp) {
                v2u w[2][2];
#pragma unroll
                for (int mm = 0; mm < 2; ++mm) { const int m = 2 * mp + mm;
                    const int row = row0 + ai * 128 + m * 16; const float s = rowf[row] * cs * (-1.4426950408889634f);
#pragma unroll
                    for (int bj = 0; bj < 2; ++bj) {
                        f32x4 v0 = acc[ai][bj][m][0] * s + bq[bj][0], v1 = acc[ai][bj][m][1] * s + bq[bj][1];
#pragma unroll
                        for (int j = 0; j < 4; ++j) { v0[j] = __builtin_amdgcn_rcpf(0.00390625f + __builtin_amdgcn_exp2f(v0[j])); v1[j] = __builtin_amdgcn_rcpf(0.00390625f + __builtin_amdgcn_exp2f(v1[j])); }
                        w[mm][bj].x = pk4_fp8(v0[0], v0[1], v0[2], v0[3]); w[mm][bj].y = pk4_fp8(v1[0], v1[1], v1[2], v1[3]);
                    }
                }
                const int rowst = row0 + ai * 128 + (2 * mp + rsel) * 16;
#pragma unroll
                for (int bj = 0; bj < 2; ++bj) *(v4u*)(gates + (size_t)rowst * GATEW + colw + bj * 128) = widen16(w[0][bj], w[1][bj]);
            }
    }
};
struct EpiMerge {
    static constexpr bool PERM = true; static constexpr int MIDK = 4;
    const unsigned char* gates; unsigned char* out; const float* swa; const float* swb;
    DI void mid(pg8::f32x4 (&acc)[2][2][4][2], const pg8::Unit& u, int wr, int wc, int fr, int fq) const {
        asm volatile("" : "+v"(fr), "+v"(fq));
        const int row0 = u.pm * 256 + wr * 64 + fr, col0 = u.pn * 256 + wc * 32 + 8 * fq;
#pragma unroll
        for (int bj = 0; bj < 2; ++bj) {
            const int col = col0 + bj * 128;
            const f32x4 a0 = *(const f32x4*)(swa + col), a1 = *(const f32x4*)(swa + col + 4), b0 = *(const f32x4*)(swb + col), b1 = *(const f32x4*)(swb + col + 4);
            f32x4 r0, r1;
#pragma unroll
            for (int j = 0; j < 4; ++j) { r0[j] = b0[j] * __builtin_amdgcn_rcpf(a0[j]); r1[j] = b1[j] * __builtin_amdgcn_rcpf(a1[j]); }
#pragma unroll
            for (int ai = 0; ai < 2; ++ai) {
#pragma unroll
                for (int mp = 0; mp < 2; ++mp) {
                    const size_t go = (size_t)(row0 + ai * 128 + (2 * mp + (fq & 1)) * 16) * GATEW + col - 8 * (fq & 1);
                    const v4u wa = *(const v4u*)(gates + go), wb = *(const v4u*)(gates + go + DM);
                    v2u ga[2], gb[2]; narrow16(wa, ga[0], ga[1]); narrow16(wb, gb[0], gb[1]);
#pragma unroll
                    for (int mm = 0; mm < 2; ++mm) { const int m = 2 * mp + mm;
                        float fa[8], fb[8]; unp8_fp8(ga[mm], fa); unp8_fp8(gb[mm], fb);
#pragma unroll
                        for (int j = 0; j < 4; ++j) {
                            acc[ai][bj][m][0][j] *= r0[j] * fb[j] * __builtin_amdgcn_rcpf(fmaxf(fa[j], 1e-30f));
                            acc[ai][bj][m][1][j] *= r1[j] * fb[4 + j] * __builtin_amdgcn_rcpf(fmaxf(fa[4 + j], 1e-30f));
                        }
                    }
                    asm volatile("" ::: "memory");
                }
            }
        }
    }
    DI void operator()(const pg8::f32x4 (&acc)[2][2][4][2], const pg8::Unit& u, int wr, int wc, int fr, int fq) const {
        const int row0 = u.pm * 256 + wr * 64 + fr, col0 = u.pn * 256 + wc * 32 + 8 * fq;
        v2u gq[2][2][4];
        {
            v4u gw_[2][2][2];
#pragma unroll
            for (int bj = 0; bj < 2; ++bj)
#pragma unroll
                for (int ai = 0; ai < 2; ++ai)
#pragma unroll
                    for (int mp = 0; mp < 2; ++mp) gw_[bj][ai][mp] = *(const v4u*)(gates + (size_t)(row0 + ai * 128 + (2 * mp + (fq & 1)) * 16) * GATEW + col0 + bj * 128 - 8 * (fq & 1));
#pragma unroll
            for (int bj = 0; bj < 2; ++bj)
#pragma unroll
                for (int ai = 0; ai < 2; ++ai)
#pragma unroll
                    for (int mp = 0; mp < 2; ++mp) narrow16(gw_[bj][ai][mp], gq[bj][ai][2 * mp], gq[bj][ai][2 * mp + 1]);
        }
#pragma unroll
        for (int bj = 0; bj < 2; ++bj) {
            const int col = col0 + bj * 128;
            const f32x4 c0 = *(const f32x4*)(swa + col) * (MSCALE / (YSCALE * 256.0f)), c1 = *(const f32x4*)(swa + col + 4) * (MSCALE / (YSCALE * 256.0f));
#pragma unroll
            for (int ai = 0; ai < 2; ++ai)
#pragma unroll
                for (int mp = 0; mp < 2; ++mp) {
                    v2u w[2];
#pragma unroll
                    for (int mm = 0; mm < 2; ++mm) { const int m = 2 * mp + mm;
                        const v2u g = gq[bj][ai][m];
                        float fg[8]; unp8_fp8(g, fg);
                        f32x4 v0 = acc[ai][bj][m][0] * c0, v1 = acc[ai][bj][m][1] * c1;
#pragma unroll
                        for (int j = 0; j < 4; ++j) { v0[j] *= fmaxf(fg[j], 1e-30f); v1[j] *= fmaxf(fg[4 + j], 1e-30f); }
                        w[mm].x = pk4_fp8(v0[0], v0[1], v0[2], v0[3]); w[mm].y = pk4_fp8(v1[0], v1[1], v1[2], v1[3]);
                    }
                    *(v4u*)(out + (size_t)(row0 + ai * 128 + (2 * mp + (fq & 1)) * 16) * DM + col - 8 * (fq & 1)) = widen16(w[0], w[1]);
                }
        }
    }
};
struct EpiOut {
    static constexpr bool PERM = true; static constexpr int MIDK = 0;
    const float* x; float* out; const float* sw; bf16* x1b; float* rowpart;
    DI void operator()(const pg8::f32x4 (&acc)[2][2][4][2], const pg8::Unit& u, int wr, int wc, int fr, int fq) const {
        const int row0 = u.pm * 256 + wr * 64 + fr, col0 = u.pn * 256 + wc * 32 + 8 * fq;
        f32x4 cs[2][2];
#pragma unroll
        for (int bj = 0; bj < 2; ++bj)
#pragma unroll
            for (int n = 0; n < 2; ++n) cs[bj][n] = *(const f32x4*)(sw + col0 + bj * 128 + n * 4) * (1.0f / MSCALE);
#pragma unroll
        for (int ai = 0; ai < 2; ++ai)
#pragma unroll
            for (int m = 0; m < 4; ++m) {
                const int row = row0 + ai * 128 + m * 16; const size_t ro = (size_t)row * DM + col0;
                float ss = 0.f;
#pragma unroll
                for (int bj = 0; bj < 2; ++bj) {
                    const f32x4 x0 = *(const f32x4*)(x + ro + bj * 128), x1 = *(const f32x4*)(x + ro + bj * 128 + 4);
                    const f32x4 v0 = x0 + acc[ai][bj][m][0] * cs[bj][0], v1 = x1 + acc[ai][bj][m][1] * cs[bj][1];
                    v4u w; w.x = pk2(v0.x, v0.y); w.y = pk2(v0.z, v0.w); w.z = pk2(v1.x, v1.y); w.w = pk2(v1.z, v1.w); *(v4u*)(x1b + ro + bj * 128) = w;
                    ss += ((v0.x * v0.x + v0.y * v0.y) + (v0.z * v0.z + v0.w * v0.w)) + ((v1.x * v1.x + v1.y * v1.y) + (v1.z * v1.z + v1.w * v1.w));
                }
                ss += __shfl_xor(ss, 16); ss += __shfl_xor(ss, 32);
                if (fq == 0) rowpart[(size_t)row * 64 + u.pn * 4 + wc] = ss;
            }
    }
};
struct EpiQ {
    static constexpr bool PERM = true; static constexpr int MIDK = 0;
    bf16* q; const LAS float* inv2l;
    DI void operator()(const pg8::f32x4 (&acc)[2][2][4][2], const pg8::Unit& u, int wr, int wc, int fr, int fq) const {
        const int rl0 = wr * 64 + fr, col0 = u.pn * 256 + wc * 32 + 8 * fq;
#pragma unroll
        for (int ai = 0; ai < 2; ++ai)
#pragma unroll
            for (int m = 0; m < 4; ++m) {
                const int rl = rl0 + ai * 128 + m * 16; const float s = inv2l[rl]; const int row = u.pm * 256 + rl;
#pragma unroll
                for (int bj = 0; bj < 2; ++bj) {
                    const f32x4 v0 = acc[ai][bj][m][0] * s, v1 = acc[ai][bj][m][1] * s;
                    v4u w; w.x = pk2(v0[0], v0[1]); w.y = pk2(v0[2], v0[3]); w.z = pk2(v1[0], v1[1]); w.w = pk2(v1[2], v1[3]);
                    *(v4u*)(q + (size_t)row * QW + col0 + bj * 128) = w;
                }
            }
    }
};

template <int MODE> DI void transpose_tile(const float* W, int N, unsigned char* dst, int ldt, int row_off, int col_off, const float* gain, float qs, LAS float* scr, int item, int lane) {
    const int nblk = N / 32, kb = item / nblk, nb = item % nblk, k0 = 128 * kb, n0 = 32 * nb;
    const int kr = lane >> 3, nc = (lane & 7) * 4;
    f32x4 v[16]; float g[16];
#pragma unroll
    for (int i = 0; i < 16; ++i) { v[i] = __builtin_nontemporal_load((const f32x4*)(W + (size_t)(k0 + 8 * i + kr) * N + n0 + nc)); g[i] = (gain ? gain[k0 + 8 * i + kr] : 1.0f) * qs; }
#pragma unroll
    for (int i = 0; i < 16; ++i) { LAS float* d = scr + (8 * i + kr) * 33 + nc; d[0] = v[i].x * g[i]; d[1] = v[i].y * g[i]; d[2] = v[i].z * g[i]; d[3] = v[i].w * g[i]; }
    asm volatile("s_waitcnt lgkmcnt(0)" ::: "memory");
    const int c = lane & 15;
#pragma unroll
    for (int j = 0; j < 8; ++j) { const int n = (lane >> 4) + 4 * j; const LAS float* s = scr + (8 * c) * 33 + n;
        unsigned char* orow = dst + (size_t)(row_off + n0 + n) * ldt + col_off;
        if constexpr (MODE == 0) { v4u o; o.x = pk2(s[0 * 33], s[1 * 33]); o.y = pk2(s[2 * 33], s[3 * 33]); o.z = pk2(s[4 * 33], s[5 * 33]); o.w = pk2(s[6 * 33], s[7 * 33]); *(v4u*)(orow + (k0 + 8 * c) * 2) = o; }
        else if constexpr (MODE == 1) { v2u o; o.x = pk4_fp8(s[0 * 33], s[1 * 33], s[2 * 33], s[3 * 33]); o.y = pk4_fp8(s[4 * 33], s[5 * 33], s[6 * 33], s[7 * 33]); *(v2u*)(orow + k0 + 8 * c) = o; }
        else {
#define SAT6(x) fminf(fmaxf((x), -6.0f), 6.0f)
            unsigned p = 0;
            p = __builtin_amdgcn_cvt_scalef32_pk_fp4_f32(p, SAT6(s[0 * 33]), SAT6(s[1 * 33]), 1.0f, 0); p = __builtin_amdgcn_cvt_scalef32_pk_fp4_f32(p, SAT6(s[2 * 33]), SAT6(s[3 * 33]), 1.0f, 1);
            p = __builtin_amdgcn_cvt_scalef32_pk_fp4_f32(p, SAT6(s[4 * 33]), SAT6(s[5 * 33]), 1.0f, 2); p = __builtin_amdgcn_cvt_scalef32_pk_fp4_f32(p, SAT6(s[6 * 33]), SAT6(s[7 * 33]), 1.0f, 3);
#undef SAT6
            *(unsigned*)(orow + (k0 + 8 * c) / 2) = p; }
    }
    asm volatile("s_waitcnt lgkmcnt(0)" ::: "memory");
}
DI void transpose_item_fp8(const float* W, int K, int N, unsigned char* WT8, int ldt, int row_off, int col_off, const float* gain, float qs, LAS float* scr, int item, int lane) {
    const int nblk = N / 64, kb = item / nblk, nb = item % nblk, k0 = 64 * kb, n0 = 64 * nb;
    const int kr = lane >> 4, nc = (lane & 15) * 4;
    f32x4 v[16]; float g[16];
#pragma unroll
    for (int i = 0; i < 16; ++i) { v[i] = __builtin_nontemporal_load((const f32x4*)(W + (size_t)(k0 + 4 * i + kr) * N + n0 + nc)); g[i] = (gain ? gain[k0 + 4 * i + kr] : 1.0f) * qs; }
#pragma unroll
    for (int i = 0; i < 16; ++i) { LAS float* d = scr + (4 * i + kr) * 65 + nc; d[0] = v[i].x * g[i]; d[1] = v[i].y * g[i]; d[2] = v[i].z * g[i]; d[3] = v[i].w * g[i]; }
    asm volatile("s_waitcnt lgkmcnt(0)" ::: "memory");
    const int c = lane & 7;
#pragma unroll
    for (int j = 0; j < 8; ++j) { const int n = (lane >> 3) + 8 * j; const LAS float* s = scr + (8 * c) * 65 + n;
        v2u o; o.x = pk4_fp8(s[0 * 65], s[1 * 65], s[2 * 65], s[3 * 65]); o.y = pk4_fp8(s[4 * 65], s[5 * 65], s[6 * 65], s[7 * 65]);
        *(v2u*)(WT8 + (size_t)(row_off + n0 + n) * ldt + col_off + k0 + 8 * c) = o; }
    asm volatile("s_waitcnt lgkmcnt(0)" ::: "memory");
}
DI void transpose_item_fp4(const float* W, int K, int N, unsigned char* WT4, int ldt, const float* gain, float qs, LAS float* scr, int item, int lane) {
    const int nblk = N / 64, kb = item / nblk, nb = item % nblk, k0 = 64 * kb, n0 = 64 * nb;
    const int kr = lane >> 4, nc = (lane & 15) * 4;
    f32x4 v[16]; float g[16];
#pragma unroll
    for (int i = 0; i < 16; ++i) { v[i] = __builtin_nontemporal_load((const f32x4*)(W + (size_t)(k0 + 4 * i + kr) * N + n0 + nc)); g[i] = (gain ? gain[k0 + 4 * i + kr] : 1.0f) * qs; }
#pragma unroll
    for (int i = 0; i < 16; ++i) { LAS float* d = scr + (4 * i + kr) * 65 + nc; d[0] = v[i].x * g[i]; d[1] = v[i].y * g[i]; d[2] = v[i].z * g[i]; d[3] = v[i].w * g[i]; }
    asm volatile("s_waitcnt lgkmcnt(0)" ::: "memory");
    const int c = lane & 7;
#pragma unroll
    for (int j = 0; j < 8; ++j) { const int n = (lane >> 3) + 8 * j; const LAS float* s = scr + (8 * c) * 65 + n;
#define SAT6(x) fminf(fmaxf((x), -6.0f), 6.0f)
        unsigned p = 0;
        p = __builtin_amdgcn_cvt_scalef32_pk_fp4_f32(p, SAT6(s[0 * 65]), SAT6(s[1 * 65]), 1.0f, 0); p = __builtin_amdgcn_cvt_scalef32_pk_fp4_f32(p, SAT6(s[2 * 65]), SAT6(s[3 * 65]), 1.0f, 1);
        p = __builtin_amdgcn_cvt_scalef32_pk_fp4_f32(p, SAT6(s[4 * 65]), SAT6(s[5 * 65]), 1.0f, 2); p = __builtin_amdgcn_cvt_scalef32_pk_fp4_f32(p, SAT6(s[6 * 65]), SAT6(s[7 * 65]), 1.0f, 3);
#undef SAT6
        *(unsigned*)(WT4 + (size_t)(n0 + n) * ldt + (k0 + 8 * c) / 2) = p; }
    asm volatile("s_waitcnt lgkmcnt(0)" ::: "memory");
}
DI void wg_sample_all(const float* w_in, const float* w_gate, const float* w_a, const float* w_b, const float* w_o, const float* gain, LAS float* red,
                      float& m_in, float& m_g, float& rms_g, float& m_a, float& m_b, float& m_o) {
    const int k = threadIdx.x >> 7, c = threadIdx.x & 127;
    f32x4 vi[8], va[4], vb[4], vo[4], vg[8];
#pragma unroll
    for (int i = 0; i < 8; ++i) vi[i] = *(const f32x4*)(w_in + (size_t)k * INW + 4 * (c + 256 * i));
#pragma unroll
    for (int i = 0; i < 4; ++i) { va[i] = *(const f32x4*)(w_a + (size_t)k * DM + 4 * (c + 256 * i)); vb[i] = *(const f32x4*)(w_b + (size_t)k * DM + 4 * (c + 256 * i)); vo[i] = *(const f32x4*)(w_o + (size_t)k * DM + 4 * (c + 256 * i)); }
#pragma unroll
    for (int i = 0; i < 8; ++i) vg[i] = *(const f32x4*)(w_gate + (size_t)k * GATEW + 4 * (c + 256 * i));
    const float g = gain[k];
    float xi = 0.f, xa = 0.f, xb = 0.f, xo = 0.f, xg = 0.f, sg = 0.f;
#pragma unroll
    for (int i = 0; i < 8; ++i) xi = fmaxf(xi, fmaxf(fmaxf(fabsf(vi[i].x), fabsf(vi[i].y)), fmaxf(fabsf(vi[i].z), fabsf(vi[i].w))));
    xi *= fabsf(g);
#pragma unroll
    for (int i = 0; i < 4; ++i) {
        xa = fmaxf(xa, fmaxf(fmaxf(fabsf(va[i].x), fabsf(va[i].y)), fmaxf(fabsf(va[i].z), fabsf(va[i].w))));
        xb = fmaxf(xb, fmaxf(fmaxf(fabsf(vb[i].x), fabsf(vb[i].y)), fmaxf(fabsf(vb[i].z), fabsf(vb[i].w))));
        xo = fmaxf(xo, fmaxf(fmaxf(fabsf(vo[i].x), fabsf(vo[i].y)), fmaxf(fabsf(vo[i].z), fabsf(vo[i].w))));
    }
#pragma unroll
    for (int i = 0; i < 8; ++i) { const float a0 = vg[i].x * g, a1 = vg[i].y * g, a2 = vg[i].z * g, a3 = vg[i].w * g; xg = fmaxf(xg, fmaxf(fmaxf(fabsf(a0), fabsf(a1)), fmaxf(fabsf(a2), fabsf(a3)))); sg += a0 * a0 + a1 * a1 + a2 * a2 + a3 * a3; }
#pragma unroll
    for (int o = 1; o < 64; o <<= 1) { xi = fmaxf(xi, __shfl_xor(xi, o)); xa = fmaxf(xa, __shfl_xor(xa, o)); xb = fmaxf(xb, __shfl_xor(xb, o)); xo = fmaxf(xo, __shfl_xor(xo, o)); xg = fmaxf(xg, __shfl_xor(xg, o)); sg += __shfl_xor(sg, o); }
    __syncthreads();
    if ((threadIdx.x & 63) == 0) { LAS float* r = red + 8 * (threadIdx.x >> 6); r[0] = xi; r[1] = xa; r[2] = xb; r[3] = xo; r[4] = xg; r[5] = sg; }
    __syncthreads();
    xi = red[0]; xa = red[1]; xb = red[2]; xo = red[3]; xg = red[4]; sg = red[5];
#pragma unroll
    for (int w = 1; w < NWAVES; ++w) { xi = fmaxf(xi, red[8 * w]); xa = fmaxf(xa, red[8 * w + 1]); xb = fmaxf(xb, red[8 * w + 2]); xo = fmaxf(xo, red[8 * w + 3]); xg = fmaxf(xg, red[8 * w + 4]); sg += red[8 * w + 5]; }
    m_in = xi; m_a = xa; m_b = xb; m_o = xo; m_g = xg; rms_g = sqrtf(sg / 16384.0f);
}
DI float wg_sample_stats(const float* W, int N, const float* gain, LAS float* red, float* rms_out) {
    float mx = 0.f, ss = 0.f;
    for (int idx = threadIdx.x; idx < N; idx += NTHREADS) {
#pragma unroll
        for (int k = 0; k < 4; ++k) { const float v = W[(size_t)k * N + idx] * (gain ? gain[k] : 1.0f); mx = fmaxf(mx, fabsf(v)); ss += v * v; }
    }
#pragma unroll
    for (int o = 1; o < 64; o <<= 1) { mx = fmaxf(mx, __shfl_xor(mx, o)); ss += __shfl_xor(ss, o); }
    __syncthreads();
    if ((threadIdx.x & 63) == 0) { red[threadIdx.x >> 6] = mx; red[8 + (threadIdx.x >> 6)] = ss; }
    __syncthreads();
    float r = red[0], s = red[8];
#pragma unroll
    for (int w = 1; w < NWAVES; ++w) { r = fmaxf(r, red[w]); s += red[8 + w]; }
    *rms_out = sqrtf(s / (4.0f * N));
    return r;
}
DI float wg_sample_absmax(const float* W, int N, const float* gain, LAS float* red) {
    float mx = 0.f;
    for (int idx = threadIdx.x; idx < N; idx += NTHREADS) {
#pragma unroll
        for (int k = 0; k < 4; ++k) mx = fmaxf(mx, fabsf(W[(size_t)k * N + idx] * (gain ? gain[k] : 1.0f)));
    }
#pragma unroll
    for (int o = 1; o < 64; o <<= 1) mx = fmaxf(mx, __shfl_xor(mx, o));
    __syncthreads();
    if ((threadIdx.x & 63) == 0) red[threadIdx.x >> 6] = mx;
    __syncthreads();
    float r = red[0];
#pragma unroll
    for (int w = 1; w < NWAVES; ++w) r = fmaxf(r, red[w]);
    return r;
}
DI void transpose_item(const float* W, int K, int N, bf16* WT, int ldt, int row_off, const float* gain, LAS float* scr, int item, int lane) {
    const int nblk = N / 64, kb = item / nblk, nb = item % nblk, k0 = 64 * kb, n0 = 64 * nb;
    const int kr = lane >> 4, nc = (lane & 15) * 4;
    f32x4 v[16]; float g[16];
#pragma unroll
    for (int i = 0; i < 16; ++i) { v[i] = __builtin_nontemporal_load((const f32x4*)(W + (size_t)(k0 + 4 * i + kr) * N + n0 + nc)); g[i] = gain ? gain[k0 + 4 * i + kr] : 1.0f; }
#pragma unroll
    for (int i = 0; i < 16; ++i) { LAS float* d = scr + (4 * i + kr) * 65 + nc; d[0] = v[i].x * g[i]; d[1] = v[i].y * g[i]; d[2] = v[i].z * g[i]; d[3] = v[i].w * g[i]; }
    asm volatile("s_waitcnt lgkmcnt(0)" ::: "memory");
    const int c = lane & 7;
#pragma unroll
    for (int j = 0; j < 8; ++j) { const int n = (lane >> 3) + 8 * j; const LAS float* s = scr + (8 * c) * 65 + n;
        v4u o; o.x = pk2(s[0 * 65], s[1 * 65]); o.y = pk2(s[2 * 65], s[3 * 65]); o.z = pk2(s[4 * 65], s[5 * 65]); o.w = pk2(s[6 * 65], s[7 * 65]);
        *(v4u*)(WT + (size_t)(row_off + n0 + n) * ldt + k0 + 8 * c) = o; }
    asm volatile("s_waitcnt lgkmcnt(0)" ::: "memory");
}

constexpr int ATT_PITCH = 272;
constexpr int ATT_SLOT = 256 * ATT_PITCH;
constexpr int ATT_ITEMS = 1024 + 768;
DI int crow(int reg, int h) { return (reg & 3) + 8 * (reg >> 2) + 4 * h; }

struct AttItem { int qcol, kcol, vcol, dil, res, n, maxd, old, hh, g; float sink; bf16* obase; bool has_lse; };
DI AttItem att_decode(int it, const float* sinks, unsigned char* ycat, bf16* outg) {
    AttItem a; a.hh = 0; a.g = 0;
    if (it < 1024) {
        const int qh = it >> 6; a.n = it & 63; a.qcol = COL_QA + qh * 128; a.kcol = COL_KA + (qh >> 2) * 128; a.vcol = COL_VA + (qh >> 2) * 128;
        a.dil = 1; a.res = 0; a.maxd = 127; a.sink = sinks[qh]; a.obase = (bf16*)(ycat + 512 + qh * 128); a.old = YCW; a.has_lse = false;
    } else {
        const int j = it - 1024; a.g = j >> 8; const int rem = j & 255; a.hh = rem >> 6; const int blk = rem & 63;
        a.dil = (a.g == 0) ? 1 : (a.g == 1 ? 4 : 16); a.res = blk % a.dil; a.n = blk / a.dil;
        const int hb = 4 * a.g + a.hh; a.qcol = COL_QB + hb * 128; a.kcol = COL_KB + hb * 128; a.vcol = COL_VB + hb * 128;
        a.maxd = 128; a.sink = -__builtin_inff(); a.obase = outg + (size_t)a.g * SEQ * 512 + a.hh * 128; a.old = 512; a.has_lse = true;
    }
    return a;
}
DI void att_fetch(v4u (&w)[16], const bf16* proj, int col, int dil, int res, int n, int st) {
    const int ch = st & 15, r0 = st >> 4;
    const size_t rstep = (size_t)16 * dil * INW;
#pragma unroll
    for (int hb = 0; hb < 2; ++hb) {
        if (n > 0 || hb == 1) {
            const bf16* gp = proj + (size_t)(res + dil * (128 * (n - 1) + 128 * hb + r0)) * INW + col + ch * 8;
#pragma unroll
            for (int ps = 0; ps < 8; ++ps) w[hb * 8 + ps] = *(const v4u*)(gp + ps * rstep);
        } else {
#pragma unroll
            for (int ps = 0; ps < 8; ++ps) w[hb * 8 + ps] = (v4u){0u, 0u, 0u, 0u};
        }
    }
}
DI void att_store(LAS unsigned char* slot, const v4u (&w)[16], int st) {
    LAS unsigned char* lp = slot + (st >> 4) * ATT_PITCH + (st & 15) * 16;
#pragma unroll
    for (int ps = 0; ps < 16; ++ps) *(LAS v4u*)(lp + ps * 16 * ATT_PITCH) = w[ps];
}

DI void attention_phase(LAS unsigned char* lds, const bf16* proj, const float* sinks, unsigned char* ycat, bf16* outg, float* lse, int bid, int G) {
    const int tid = threadIdx.x, lane = tid & 63, wave = __builtin_amdgcn_readfirstlane(tid >> 6);
    const int slot_id = wave >> 2, w = wave & 3, st = tid & 255;
    const int r = lane & 31, h = lane >> 5;
    LAS unsigned char* slot = lds + slot_id * ATT_SLOT;
    const float c_scale = 0.08838834764831845f, LOG2E = 1.4426950408889634f;
    v4u kw[16];
    if (bid < ATT_ITEMS / 2) { const AttItem a0 = att_decode(2 * bid + slot_id, sinks, ycat, outg); att_fetch(kw, proj, a0.kcol, a0.dil, a0.res, a0.n, st); }
#pragma unroll 1
    for (int pair = bid; pair < ATT_ITEMS / 2; pair += G) {
        const AttItem a = att_decode(2 * pair + slot_id, sinks, ycat, outg);
        const int n = a.n;
        att_store(slot, kw, st);
        const int iq = 128 * n + 32 * w + r, qpos = a.res + a.dil * iq;
        bf16x8 qf[8];
#pragma unroll
        for (int ks = 0; ks < 8; ++ks) qf[ks] = *(const bf16x8*)(proj + (size_t)qpos * INW + a.qcol + 16 * ks + 8 * h);
        __syncthreads();
        f32x16 sacc[5];
#pragma unroll
        for (int kbi = 0; kbi < 5; ++kbi) {
#pragma unroll
            for (int i = 0; i < 16; ++i) sacc[kbi][i] = 0.f;
#pragma unroll
            for (int ks = 0; ks < 8; ++ks) {
                const bf16x8 af = *(const LAS bf16x8*)(slot + (32 * (w + kbi) + r) * ATT_PITCH + (16 * ks + 8 * h) * 2);
                sacc[kbi] = __builtin_amdgcn_mfma_f32_32x32x16_bf16(af, qf[ks], sacc[kbi], 0, 0, 0);
            }
            asm volatile("" ::: "memory");
        }
        v4u vw[16];
        att_fetch(vw, proj, a.vcol, a.dil, a.res, n, st);
        int base = r - 4 * h; asm volatile("" : "+v"(base));
        const int lim = (n > 0) ? a.maxd : min(a.maxd, 32 * w + r);
        float mx = -__builtin_inff();
#pragma unroll
        for (int kbi = 0; kbi < 5; ++kbi)
#pragma unroll
            for (int i = 0; i < 16; ++i) {
                const int dist = base + (128 - 32 * kbi - (i & 3) - 8 * (i >> 2));
                const bool valid = (unsigned)dist <= (unsigned)lim;
                const float s = valid ? sacc[kbi][i] : -__builtin_inff();
                sacc[kbi][i] = s; mx = fmaxf(mx, s);
            }
        mx = fmaxf(mx, __shfl_xor(mx, 32));
        const float m_sc = fmaxf(mx * c_scale, a.sink);
        const float mb = m_sc * LOG2E, c2 = c_scale * LOG2E;
        float l = 0.f;
#pragma unroll
        for (int kbi = 0; kbi < 5; ++kbi)
#pragma unroll
            for (int i = 0; i < 16; ++i) { const float p = __builtin_amdgcn_exp2f(sacc[kbi][i] * c2 - mb); sacc[kbi][i] = p; l += p; }
        l += __shfl_xor(l, 32);
        l += __builtin_amdgcn_exp2f(a.sink * LOG2E - mb);
        const float rl = 1.0f / l;
        if (a.has_lse && h == 0) lse[((size_t)a.g * SEQ + qpos) * 4 + a.hh] = m_sc + __logf(l);
        bf16x8 pf[5][2];
#pragma unroll
        for (int kbi = 0; kbi < 5; ++kbi)
#pragma unroll
            for (int s = 0; s < 2; ++s) {
                v4u pw; pw.x = pk2(sacc[kbi][8 * s + 0], sacc[kbi][8 * s + 1]); pw.y = pk2(sacc[kbi][8 * s + 2], sacc[kbi][8 * s + 3]);
                pw.z = pk2(sacc[kbi][8 * s + 4], sacc[kbi][8 * s + 5]); pw.w = pk2(sacc[kbi][8 * s + 6], sacc[kbi][8 * s + 7]);
                pf[kbi][s] = __builtin_bit_cast(bf16x8, pw);
            }
        __syncthreads();
        att_store(slot, vw, st);
        __syncthreads();
        { const int pnx = (pair + G < ATT_ITEMS / 2) ? pair + G : pair;
          const AttItem an = att_decode(2 * pnx + slot_id, sinks, ycat, outg); att_fetch(kw, proj, an.kcol, an.dil, an.res, an.n, st); }
        f32x16 oacc[4];
#pragma unroll
        for (int db = 0; db < 4; ++db)
#pragma unroll
            for (int i = 0; i < 16; ++i) oacc[db][i] = 0.f;
        const int q4 = (lane & 15) >> 2, p4 = lane & 3, blk16 = (lane >> 4) & 1;
#pragma unroll
        for (int kbi = 0; kbi < 5; ++kbi)
#pragma unroll
            for (int s = 0; s < 2; ++s) {
                const int key0 = 32 * (w + kbi) + 16 * s + 4 * h + q4;
#pragma unroll
                for (int db = 0; db < 4; ++db) {
                    const LAS unsigned char* a0 = slot + key0 * ATT_PITCH + (32 * db + 16 * blk16) * 2 + 8 * p4;
                    const s16x4 lo = __builtin_amdgcn_ds_read_tr16_b64_v4i16((LAS s16x4*)a0);
                    const s16x4 hi = __builtin_amdgcn_ds_read_tr16_b64_v4i16((LAS s16x4*)(a0 + 8 * ATT_PITCH));
                    const bf16x8 va = __builtin_shufflevector(lo, hi, 0, 1, 2, 3, 4, 5, 6, 7);
                    oacc[db] = __builtin_amdgcn_mfma_f32_32x32x16_bf16(va, pf[kbi][s], oacc[db], 0, 0, 0);
                }
                asm volatile("" ::: "memory");
            }
        if (a.has_lse) {
            bf16* orow = a.obase + (size_t)qpos * a.old;
#pragma unroll
            for (int db = 0; db < 4; ++db) {
                v2u o[4];
#pragma unroll
                for (int g4 = 0; g4 < 4; ++g4) { o[g4].x = pk2(oacc[db][4 * g4 + 0] * rl, oacc[db][4 * g4 + 1] * rl); o[g4].y = pk2(oacc[db][4 * g4 + 2] * rl, oacc[db][4 * g4 + 3] * rl); }
                const auto s02x = __builtin_amdgcn_permlane32_swap(o[0].x, o[2].x, false, false), s02y = __builtin_amdgcn_permlane32_swap(o[0].y, o[2].y, false, false);
                const auto s13x = __builtin_amdgcn_permlane32_swap(o[1].x, o[3].x, false, false), s13y = __builtin_amdgcn_permlane32_swap(o[1].y, o[3].y, false, false);
                *(v4u*)(orow + 32 * db + 16 * h) = (v4u){s02x[0], s02y[0], s02x[1], s02y[1]};
                *(v4u*)(orow + 32 * db + 16 * h + 8) = (v4u){s13x[0], s13y[0], s13x[1], s13y[1]};
            }
        } else {
            unsigned char* orow = (unsigned char*)a.obase + (size_t)qpos * a.old; const float rs = rl * YSCALE;
#pragma unroll
            for (int db = 0; db < 4; ++db) {
                unsigned d[4];
#pragma unroll
                for (int g4 = 0; g4 < 4; ++g4) d[g4] = pk4_fp8(oacc[db][4 * g4 + 0] * rs, oacc[db][4 * g4 + 1] * rs, oacc[db][4 * g4 + 2] * rs, oacc[db][4 * g4 + 3] * rs);
                const auto s02 = __builtin_amdgcn_permlane32_swap(d[0], d[2], false, false), s13 = __builtin_amdgcn_permlane32_swap(d[1], d[3], false, false);
                *(v4u*)(orow + 32 * db + 16 * h) = (v4u){s02[0], s02[1], s13[0], s13[1]};
            }
        }
        __syncthreads();
    }
}

DI void combine_phase(const bf16* outg, const float* lse, unsigned char* ycat, int gtid, int gthreads) {
    for (int idx = gtid; idx < SEQ * 64; idx += gthreads) {
        const int t = idx >> 6, ch = idx & 63, hh = ch >> 4, dd = (ch & 15) * 8;
        const float l0 = lse[((size_t)0 * SEQ + t) * 4 + hh], l1 = lse[((size_t)1 * SEQ + t) * 4 + hh], l2 = lse[((size_t)2 * SEQ + t) * 4 + hh];
        const float m = fmaxf(l0, fmaxf(l1, l2));
        float w0 = __expf(l0 - m), w1 = __expf(l1 - m), w2 = __expf(l2 - m); const float rs = 1.0f / (w0 + w1 + w2); w0 *= rs; w1 *= rs; w2 *= rs;
        const v4u a = *(const v4u*)(outg + ((size_t)0 * SEQ + t) * 512 + hh * 128 + dd);
        const v4u b = *(const v4u*)(outg + ((size_t)1 * SEQ + t) * 512 + hh * 128 + dd);
        const v4u c = *(const v4u*)(outg + ((size_t)2 * SEQ + t) * 512 + hh * 128 + dd);
        w0 *= YSCALE; w1 *= YSCALE; w2 *= YSCALE;
        v2u o;
        o.x = pk4_fp8(w0 * bflo(a.x) + w1 * bflo(b.x) + w2 * bflo(c.x), w0 * bfhi(a.x) + w1 * bfhi(b.x) + w2 * bfhi(c.x), w0 * bflo(a.y) + w1 * bflo(b.y) + w2 * bflo(c.y), w0 * bfhi(a.y) + w1 * bfhi(b.y) + w2 * bfhi(c.y));
        o.y = pk4_fp8(w0 * bflo(a.z) + w1 * bflo(b.z) + w2 * bflo(c.z), w0 * bfhi(a.z) + w1 * bfhi(b.z) + w2 * bfhi(c.z), w0 * bflo(a.w) + w1 * bflo(b.w) + w2 * bflo(c.w), w0 * bfhi(a.w) + w1 * bfhi(b.w) + w2 * bfhi(c.w));
        *(v2u*)(ycat + (size_t)t * YCW + hh * 128 + dd) = o;
    }
}

constexpr int RT_PITCH = 129;
DI int f2key(float f) { const int b = __builtin_bit_cast(int, f); return b ^ ((b >> 31) & 0x7fffffff); }
DI float key2f(int k) { const int b = k ^ ((k >> 31) & 0x7fffffff); return __builtin_bit_cast(float, b); }
#define TOPK_INSERT(arr, xx) do { int _x = (xx); _Pragma("unroll") for (int _j = 0; _j < 16; ++_j) { const int _hi = max(arr[_j], _x); _x = min(arr[_j], _x); arr[_j] = _hi; } } while (0)

DI void routing_block(LAS unsigned char* lds, const bf16* q, const bf16* skb, int* experts, float* pgates, int tb) {
    int tid = threadIdx.x; asm volatile("" : "+v"(tid));
    const int lane = tid & 63, wave = __builtin_amdgcn_readfirstlane(tid >> 6);
    const int r = lane & 31, h = lane >> 5;
    LAS int* sc = (LAS int*)lds;
#pragma unroll 1
    for (int hp = 0; hp < 2; ++hp) {
        const int t0 = tb * 32, hc = 8 * hp + wave;
        f32x16 acc[4];
#pragma unroll
        for (int kb = 0; kb < 4; ++kb)
#pragma unroll
            for (int i = 0; i < 16; ++i) acc[kb][i] = 0.f;
#pragma unroll
        for (int ks = 0; ks < 8; ++ks) {
            const bf16x8 a = *(const bf16x8*)(q + (size_t)(t0 + r) * QW + hc * 128 + 16 * ks + 8 * h);
#pragma unroll
            for (int kb = 0; kb < 4; ++kb) {
                const bf16x8 b = *(const bf16x8*)(skb + ((size_t)hc * 128 + 32 * kb + r) * 128 + 16 * ks + 8 * h);
                acc[kb] = __builtin_amdgcn_mfma_f32_32x32x16_bf16(a, b, acc[kb], 0, 0, 0);
            }
        }
#pragma unroll
        for (int kb = 0; kb < 4; ++kb)
#pragma unroll
            for (int i = 0; i < 16; ++i) {
                const int key = 32 * kb + r;
                sc[(crow(i, h) * 8 + wave) * RT_PITCH + key] = (f2key(acc[kb][i]) & ~127) | key;
            }
        __syncthreads();
        {
            int a[16];
#pragma unroll
            for (int j = 0; j < 16; ++j) a[j] = (int)0x80000000;
            LAS int* row = sc + (tid >> 1) * RT_PITCH; const int hf = tid & 1;
#pragma unroll 8
            for (int k = 0; k < 64; ++k) { const int x = row[64 * hf + k]; TOPK_INSERT(a, x); }
            __syncthreads();
#pragma unroll
            for (int j = 0; j < 16; ++j) row[16 * hf + j] = a[j];
            __syncthreads();
            if (hf == 0) {
#pragma unroll
                for (int j = 0; j < 16; ++j) { const int x = row[16 + j]; TOPK_INSERT(a, x); }
#pragma unroll
                for (int j = 0; j < 16; ++j) row[j] = a[j];
            }
        }
        __syncthreads();
        if (tid < 128) {
            LAS int* ra = sc + (2 * tid) * RT_PITCH; LAS int* rb = ra + RT_PITCH;
            float va[16], vb[16];
#pragma unroll
            for (int j = 0; j < 16; ++j) { va[j] = key2f(ra[j] & ~127); vb[j] = key2f(rb[j] & ~127); }
            int c[16];
#pragma unroll
            for (int j = 0; j < 16; ++j) c[j] = (int)0x80000000;
#pragma unroll
            for (int i = 0; i < 16; ++i)
#pragma unroll
                for (int j = 0; j < 16; ++j)
                    if ((i + 1) * (j + 1) <= 16) { const int x = (f2key(va[i] + vb[j]) & ~255) | (i * 16 + j); TOPK_INSERT(c, x); }
            int ex[16];
#pragma unroll
            for (int k = 0; k < 16; ++k) { const int id = c[k] & 255; ex[k] = (ra[id >> 4] & 127) * 128 + (rb[id & 15] & 127); }
            float e[16]; const float m0 = key2f(c[0] & ~255); float s2 = 0.f;
#pragma unroll
            for (int k = 0; k < 16; ++k) { e[k] = __expf(key2f(c[k] & ~255) - m0); s2 += e[k]; }
            const float rs = 1.0f / s2;
            const int t = t0 + (tid >> 2), hd = 4 * hp + (tid & 3);
            int* ep = experts + (size_t)t * 128 + hd * 16; float* gp = pgates + (size_t)t * 128 + hd * 16;
#pragma unroll
            for (int k4 = 0; k4 < 4; ++k4) {
                *(int4*)(ep + 4 * k4) = make_int4(ex[4 * k4], ex[4 * k4 + 1], ex[4 * k4 + 2], ex[4 * k4 + 3]);
                *(f32x4*)(gp + 4 * k4) = (f32x4){e[4 * k4] * rs, e[4 * k4 + 1] * rs, e[4 * k4 + 2] * rs, e[4 * k4 + 3] * rs};
            }
        }
        __syncthreads();
    }
}

typedef float f32x32 __attribute__((ext_vector_type(32)));
typedef unsigned v6u __attribute__((ext_vector_type(6)));
typedef unsigned v16u __attribute__((ext_vector_type(16)));
typedef __bf16 bf16x32 __attribute__((ext_vector_type(32)));
constexpr int ROW4 = 2048, RSLOT = 2 * ROW4;
DI float readlane_f(float v, int l) { return __builtin_bit_cast(float, __builtin_amdgcn_readlane(__builtin_bit_cast(int, v), l)); }
DI float wave_sum_dpp(float v) {
#define DPPF(x, ctrl, rmask) __builtin_bit_cast(float, __builtin_amdgcn_update_dpp(0, __builtin_bit_cast(int, x), ctrl, rmask, 0xf, false))
    v += DPPF(v, 0xB1, 0xf); v += DPPF(v, 0x4E, 0xf); v += DPPF(v, 0x141, 0xf); v += DPPF(v, 0x140, 0xf);
    v += DPPF(v, 0x142, 0xa); v += DPPF(v, 0x143, 0xc);
#undef DPPF
    return readlane_f(v, 63);
}
DI float gelu_exact(float v) {
    const float av = fabsf(v), t = __builtin_amdgcn_rcpf(av * 0.2316418882f + 1.0f);
    float q = t * 0.5307027145f + (-0.7265760135f); q = q * t + 0.7107068705f; q = q * t + (-0.142248368f); q = q * t + 0.127414796f; q = q * t;
    const float e = __builtin_amdgcn_exp2f((v * v) * (-0.72134752044f));
    const float m = v * (q * e);
    return v < 0.f ? m : v - m;
}
#define P11_DMA(gsrc, ldst, NP) do { _Pragma("unroll") for (int _i = 0; _i < (NP); ++_i) \
    __builtin_amdgcn_global_load_lds((const unsigned*)((gsrc) + _i * 1024), (LAS unsigned*)((ldst) + _i * 1024), 16, 0, 0); } while (0)
DI void peer_token(LAS unsigned char* ring, const bf16* x1row, float inv2, const float* nffn, const int* ex, const float* pg, const unsigned char* U6, const unsigned char* V6,
                   const float* usc, const float* vsc, float* orow, int lane) {
    unsigned k0 = ((unsigned)__hip_atomic_load(ex + lane, __ATOMIC_RELAXED, __HIP_MEMORY_SCOPE_AGENT) << 7) | (unsigned)lane;
    unsigned k1 = ((unsigned)__hip_atomic_load(ex + 64 + lane, __ATOMIC_RELAXED, __HIP_MEMORY_SCOPE_AGENT) << 7) | (unsigned)(64 + lane);
#define P11_CX(J, ASC0, ASC1) do { const unsigned o0_ = (unsigned)__shfl_xor((int)k0, (J)), o1_ = (unsigned)__shfl_xor((int)k1, (J)); const bool lowl_ = (lane & (J)) == 0; \
        k0 = (lowl_ == (ASC0)) ? (k0 < o0_ ? k0 : o0_) : (k0 > o0_ ? k0 : o0_); k1 = (lowl_ == (ASC1)) ? (k1 < o1_ ? k1 : o1_) : (k1 > o1_ ? k1 : o1_); } while (0)
#pragma unroll
    for (int kk = 2; kk <= 32; kk <<= 1) { const bool asc = (lane & kk) == 0;
#pragma unroll
        for (int j = kk >> 1; j >= 1; j >>= 1) P11_CX(j, asc, asc); }
#pragma unroll
    for (int j = 32; j >= 1; j >>= 1) P11_CX(j, true, false);
    { const unsigned lo_ = k0 < k1 ? k0 : k1, hi_ = k0 < k1 ? k1 : k0; k0 = lo_; k1 = hi_; }
#pragma unroll
    for (int j = 32; j >= 1; j >>= 1) P11_CX(j, true, true);
#undef P11_CX
    const int e_lo = (int)(k0 >> 7), e_hi = (int)(k1 >> 7);
    const float us_lo = usc[e_lo], us_hi = usc[e_hi];
    const float gv_lo = __hip_atomic_load(pg + (k0 & 127u), __ATOMIC_RELAXED, __HIP_MEMORY_SCOPE_AGENT) * vsc[e_lo], gv_hi = __hip_atomic_load(pg + (k1 & 127u), __ATOMIC_RELAXED, __HIP_MEMORY_SCOPE_AGENT) * vsc[e_hi];
    f32x2 h2[32], y[32];
    asm volatile("" : "+s"(nffn));
#pragma unroll
    for (int i = 0; i < 16; ++i) {
        const v2u aw = *(const v2u*)(x1row + i * 256 + lane * 4); const f32x4 g = *(const f32x4*)(nffn + i * 256 + lane * 4);
        h2[2 * i] = (f32x2){bflo(aw.x) * inv2 * g.x, bfhi(aw.x) * inv2 * g.y}; h2[2 * i + 1] = (f32x2){bflo(aw.y) * inv2 * g.z, bfhi(aw.y) * inv2 * g.w};
    }
#pragma unroll
    for (int i = 0; i < 32; ++i) y[i] = (f32x2){0.f, 0.f};
    asm volatile("s_waitcnt vmcnt(0)" ::: "memory");
    const unsigned char* ul = U6 + lane * 16; const unsigned char* vl = V6 + lane * 16;
    {
#pragma unroll
        for (int j = 0; j < 8; ++j) { const int ej = __builtin_amdgcn_readlane(e_lo, j); P11_DMA(ul + (size_t)ej * ROW4, ring + j * ROW4, 2); }
    }
    float cf_lo = 0.f, cf_hi = 0.f;
#define P11_ROW(k, NEXT_BASE, NEXT_REG, NEXT_LANE, W) \
        LAS unsigned char* su = ring + ((k) & 7) * ROW4; \
        const int en = __builtin_amdgcn_readlane(NEXT_REG, NEXT_LANE); \
        asm volatile("s_waitcnt vmcnt(14)" ::: "memory");            \
        v4u W[2]; \
        _Pragma("unroll") for (int i = 0; i < 2; ++i) W[i] = *(const LAS v4u*)(su + i * 1024 + lane * 16); \
        asm volatile("s_waitcnt lgkmcnt(0)" ::: "memory"); \
        P11_DMA((NEXT_BASE) + (size_t)en * ROW4, su, 2);
#define P11_U(k, US_REG, GV_REG, CF_REG, NEXT_BASE, NEXT_REG, NEXT_LANE) do { \
        P11_ROW(k, NEXT_BASE, NEXT_REG, NEXT_LANE, uw) \
        const float usk = readlane_f(US_REG, (k) & 63), gvk = readlane_f(GV_REG, (k) & 63); \
        f32x2 d0 = {0.f, 0.f}, d1 = {0.f, 0.f}, d2 = {0.f, 0.f}, d3 = {0.f, 0.f}; \
        { const unsigned w8[8] = {uw[0].x, uw[0].y, uw[0].z, uw[0].w, uw[1].x, uw[1].y, uw[1].z, uw[1].w}; \
          _Pragma("unroll") for (int w = 0; w < 8; ++w) { \
            d0 = __builtin_amdgcn_cvt_scalef32_pk_f32_fp4(w8[w], 1.0f, 0) * h2[4 * w + 0] + d0; d1 = __builtin_amdgcn_cvt_scalef32_pk_f32_fp4(w8[w], 1.0f, 1) * h2[4 * w + 1] + d1; \
            d2 = __builtin_amdgcn_cvt_scalef32_pk_f32_fp4(w8[w], 1.0f, 2) * h2[4 * w + 2] + d2; d3 = __builtin_amdgcn_cvt_scalef32_pk_f32_fp4(w8[w], 1.0f, 3) * h2[4 * w + 3] + d3; } } \
        const f32x2 ds = (d0 + d1) + (d2 + d3); \
        const float d = wave_sum_dpp(ds.x + ds.y) * usk; \
        const float cf = gelu_exact(d) * gvk; \
        CF_REG = (lane == ((k) & 63)) ? cf : CF_REG; } while (0)
#define P11_V(k, CF_REG, NEXT_BASE, NEXT_REG, NEXT_LANE) do { \
        P11_ROW(k, NEXT_BASE, NEXT_REG, NEXT_LANE, vw) \
        const float cfk = readlane_f(CF_REG, (k) & 63); const f32x2 cf2_ = {cfk, cfk}; \
        const unsigned w8_[8] = {vw[0].x, vw[0].y, vw[0].z, vw[0].w, vw[1].x, vw[1].y, vw[1].z, vw[1].w}; \
        _Pragma("unroll") for (int w_ = 0; w_ < 8; ++w_) { \
            y[4 * w_ + 0] = __builtin_amdgcn_cvt_scalef32_pk_f32_fp4(w8_[w_], 1.0f, 0) * cf2_ + y[4 * w_ + 0]; y[4 * w_ + 1] = __builtin_amdgcn_cvt_scalef32_pk_f32_fp4(w8_[w_], 1.0f, 1) * cf2_ + y[4 * w_ + 1]; \
            y[4 * w_ + 2] = __builtin_amdgcn_cvt_scalef32_pk_f32_fp4(w8_[w_], 1.0f, 2) * cf2_ + y[4 * w_ + 2]; y[4 * w_ + 3] = __builtin_amdgcn_cvt_scalef32_pk_f32_fp4(w8_[w_], 1.0f, 3) * cf2_ + y[4 * w_ + 3]; } } while (0)
#pragma unroll 2
    for (int k = 0; k < 56; ++k) P11_U(k, us_lo, gv_lo, cf_lo, ul, e_lo, k + 8);
#pragma unroll 1
    for (int k = 56; k < 64; ++k) P11_U(k, us_lo, gv_lo, cf_lo, ul, e_hi, k - 56);
#pragma unroll 2
    for (int k = 64; k < 120; ++k) P11_U(k, us_hi, gv_hi, cf_hi, ul, e_hi, k - 56);
#pragma unroll 1
    for (int k = 120; k < 128; ++k) P11_U(k, us_hi, gv_hi, cf_hi, vl, e_lo, k - 120);
#pragma unroll 1
    for (int k = 0; k < 56; ++k) P11_V(k, cf_lo, vl, e_lo, k + 8);
#pragma unroll 1
    for (int k = 56; k < 64; ++k) P11_V(k, cf_lo, vl, e_hi, k - 56);
#pragma unroll 1
    for (int k = 64; k < 120; ++k) P11_V(k, cf_hi, vl, e_hi, k - 56);
#pragma unroll 1
    for (int k = 120; k < 128; ++k) P11_V(k, cf_hi, vl, e_lo, k - 120);
#undef P11_ROW
#undef P11_U
#undef P11_V
    const float ysc = 1.0f;
    asm volatile("s_waitcnt vmcnt(0)" ::: "memory");
#pragma unroll
    for (int i = 0; i < 16; ++i) {
        const v2u aw = *(const v2u*)(x1row + i * 256 + lane * 4);
        *(f32x4*)(orow + i * 256 + lane * 4) = (f32x4){bflo(aw.x) + ysc * y[2 * i].x, bfhi(aw.x) + ysc * y[2 * i].y, bflo(aw.y) + ysc * y[2 * i + 1].x, bfhi(aw.y) + ysc * y[2 * i + 1].y};
    }
}
DI void row_load(const float* xrow, f32x4 (&v)[16], int lane) {
#pragma unroll
    for (int i = 0; i < 16; ++i) v[i] = __builtin_nontemporal_load((const f32x4*)(xrow + i * 256 + lane * 4));
}
DI void row_emit_fp4(const f32x4 (&v)[16], unsigned char* orow, float* sc_out, int lane);
DI void row_to_fp4(const float* xrow, unsigned char* orow, float* sc_out, int lane) { f32x4 v[16]; row_load(xrow, v, lane); row_emit_fp4(v, orow, sc_out, lane); }
DI void row_emit_fp4(const f32x4 (&v)[16], unsigned char* orow, float* sc_out, int lane) {
    float mx = 0.f, ss = 0.f;
#pragma unroll
    for (int i = 0; i < 16; ++i) { const f32x4 a = v[i];
        mx = fmaxf(mx, fmaxf(fmaxf(fabsf(a.x), fabsf(a.y)), fmaxf(fabsf(a.z), fabsf(a.w)))); ss += (a.x * a.x + a.y * a.y) + (a.z * a.z + a.w * a.w); }
#pragma unroll
    for (int o = 1; o < 64; o <<= 1) { mx = fmaxf(mx, __shfl_xor(mx, o)); ss += __shfl_xor(ss, o); }
    const float top = fminf(mx, 3.0f * sqrtf(ss * (1.0f / DM)));
    const float s = top > 0.f ? 6.0f / top : 1.0f;
    if (lane == 0) *sc_out = top > 0.f ? top * (1.0f / 6.0f) : 1.0f;
    unsigned pk[8];
#pragma unroll
    for (int w = 0; w < 8; ++w) {
        unsigned p = 0;
#define SAT6(x) fminf(fmaxf((x), -6.0f), 6.0f)
        p = __builtin_amdgcn_cvt_scalef32_pk_fp4_f32(p, SAT6(v[2 * w].x * s), SAT6(v[2 * w].y * s), 1.0f, 0);
        p = __builtin_amdgcn_cvt_scalef32_pk_fp4_f32(p, SAT6(v[2 * w].z * s), SAT6(v[2 * w].w * s), 1.0f, 1);
        p = __builtin_amdgcn_cvt_scalef32_pk_fp4_f32(p, SAT6(v[2 * w + 1].x * s), SAT6(v[2 * w + 1].y * s), 1.0f, 2);
        p = __builtin_amdgcn_cvt_scalef32_pk_fp4_f32(p, SAT6(v[2 * w + 1].z * s), SAT6(v[2 * w + 1].w * s), 1.0f, 3);
#undef SAT6
        pk[w] = p;
    }
#pragma unroll
    for (int p = 0; p < 2; ++p) *(v4u*)(orow + p * 1024 + lane * 16) = (v4u){pk[4 * p], pk[4 * p + 1], pk[4 * p + 2], pk[4 * p + 3]};
}
DI void xrow_to_fp8(const float* xrow, unsigned char* orow, float* rowf_out, unsigned char* orow4, float* rowf4_out, int lane) {
    f32x4 v[16]; float mx = 0.f, ss = 0.f;
#pragma unroll
    for (int i = 0; i < 4; ++i)
#pragma unroll
        for (int jj = 0; jj < 4; ++jj) { const f32x4 a = *(const f32x4*)(xrow + i * 1024 + lane * 16 + jj * 4); v[i * 4 + jj] = a;
            mx = fmaxf(mx, fmaxf(fmaxf(fabsf(a.x), fabsf(a.y)), fmaxf(fabsf(a.z), fabsf(a.w)))); ss += (a.x * a.x + a.y * a.y) + (a.z * a.z + a.w * a.w); }
#pragma unroll
    for (int o = 1; o < 64; o <<= 1) { mx = fmaxf(mx, __shfl_xor(mx, o)); ss += __shfl_xor(ss, o); }
    const float s = mx > 0.f ? 256.0f / mx : 1.0f;
    const float rms = sqrtf(ss * (1.0f / DM)), inv = 1.0f / sqrtf(ss * (1.0f / DM) + EPS);
    const float top4 = fminf(mx, 3.0f * rms), s4 = top4 > 0.f ? 6.0f / top4 : 1.0f;
    if (lane == 0) { *rowf_out = (mx > 0.f ? mx * (1.0f / 256.0f) : 1.0f) * inv; *rowf4_out = (top4 > 0.f ? top4 * (1.0f / 6.0f) : 1.0f) * inv; }
#pragma unroll
    for (int i = 0; i < 4; ++i) {
        v4u o;
        o.x = pk4_fp8(v[i * 4 + 0].x * s, v[i * 4 + 0].y * s, v[i * 4 + 0].z * s, v[i * 4 + 0].w * s); o.y = pk4_fp8(v[i * 4 + 1].x * s, v[i * 4 + 1].y * s, v[i * 4 + 1].z * s, v[i * 4 + 1].w * s);
        o.z = pk4_fp8(v[i * 4 + 2].x * s, v[i * 4 + 2].y * s, v[i * 4 + 2].z * s, v[i * 4 + 2].w * s); o.w = pk4_fp8(v[i * 4 + 3].x * s, v[i * 4 + 3].y * s, v[i * 4 + 3].z * s, v[i * 4 + 3].w * s);
        *(v4u*)(orow + i * 1024 + lane * 16) = o;
#define SAT6(x) fminf(fmaxf((x), -6.0f), 6.0f)
        v2u q;
        { unsigned p = 0; p = __builtin_amdgcn_cvt_scalef32_pk_fp4_f32(p, SAT6(v[i * 4 + 0].x * s4), SAT6(v[i * 4 + 0].y * s4), 1.0f, 0); p = __builtin_amdgcn_cvt_scalef32_pk_fp4_f32(p, SAT6(v[i * 4 + 0].z * s4), SAT6(v[i * 4 + 0].w * s4), 1.0f, 1);
          p = __builtin_amdgcn_cvt_scalef32_pk_fp4_f32(p, SAT6(v[i * 4 + 1].x * s4), SAT6(v[i * 4 + 1].y * s4), 1.0f, 2); p = __builtin_amdgcn_cvt_scalef32_pk_fp4_f32(p, SAT6(v[i * 4 + 1].z * s4), SAT6(v[i * 4 + 1].w * s4), 1.0f, 3); q.x = p; }
        { unsigned p = 0; p = __builtin_amdgcn_cvt_scalef32_pk_fp4_f32(p, SAT6(v[i * 4 + 2].x * s4), SAT6(v[i * 4 + 2].y * s4), 1.0f, 0); p = __builtin_amdgcn_cvt_scalef32_pk_fp4_f32(p, SAT6(v[i * 4 + 2].z * s4), SAT6(v[i * 4 + 2].w * s4), 1.0f, 1);
          p = __builtin_amdgcn_cvt_scalef32_pk_fp4_f32(p, SAT6(v[i * 4 + 3].x * s4), SAT6(v[i * 4 + 3].y * s4), 1.0f, 2); p = __builtin_amdgcn_cvt_scalef32_pk_fp4_f32(p, SAT6(v[i * 4 + 3].z * s4), SAT6(v[i * 4 + 3].w * s4), 1.0f, 3); q.y = p; }
#undef SAT6
        *(v2u*)(orow4 + i * 512 + lane * 8) = q;
    }
}
#ifndef LATE_ROWS
#define LATE_ROWS 16
#endif
struct Args { const void* in[19]; float* out; unsigned char* ws; int ph_lo, ph_hi; };
DI void conv_rows(LAS unsigned char* lds, int m_lo, int m_hi) {
    const __attribute__((address_space(4))) Args* ka = (const __attribute__((address_space(4))) Args*)__builtin_amdgcn_kernarg_segment_ptr();
    asm volatile("" : "+s"(ka));
    int tid = threadIdx.x; asm volatile("" : "+v"(tid));
    const int lane = tid & 63, wave = __builtin_amdgcn_readfirstlane(tid >> 6);
    const int gw = blockIdx.x * NWAVES + wave, NGW = gridDim.x * NWAVES;
    unsigned char* ws = ka->ws;
    const float* peer_u = (const float*)ka->in[17]; const float* peer_v = (const float*)ka->in[18];
    unsigned char* U8 = ws + WS_U; unsigned char* V8 = ws + WS_V; float* usc = (float*)(ws + WS_USC); float* vsc = (float*)(ws + WS_VSC);
    LAS unsigned char* buf = lds + wave * 16896;
#define CONV_SRC(m) ((const unsigned char*)((m) < NEXP ? peer_u + (size_t)(m) * DM : peer_v + (size_t)((m) - NEXP) * DM) + lane * 16)
    if (m_lo + gw < m_hi) P11_DMA(CONV_SRC(m_lo + gw), buf, 16);
#pragma unroll 1
    for (int m = m_lo + gw; m < m_hi; m += NGW) {
        asm volatile("s_waitcnt vmcnt(0)" ::: "memory");
        f32x4 v[16];
#pragma unroll
        for (int i = 0; i < 16; ++i) v[i] = *(const LAS f32x4*)(buf + i * 1024 + lane * 16);
        asm volatile("s_waitcnt lgkmcnt(0)" ::: "memory");
        const int mn = m + NGW;
        if (mn < m_hi) P11_DMA(CONV_SRC(mn), buf, 16);
        if (m < NEXP) row_emit_fp4(v, U8 + (size_t)m * ROW4, usc + m, lane); else row_emit_fp4(v, V8 + (size_t)(m - NEXP) * ROW4, vsc + (m - NEXP), lane);
    }
    asm volatile("s_waitcnt vmcnt(0)" ::: "memory");
#undef CONV_SRC
}
DI void conv_job(LAS unsigned char* lds) {
    const __attribute__((address_space(4))) Args* ka = (const __attribute__((address_space(4))) Args*)__builtin_amdgcn_kernarg_segment_ptr();
    asm volatile("" : "+s"(ka));
    int tid = threadIdx.x; asm volatile("" : "+v"(tid));
    const int lane = tid & 63, wave = __builtin_amdgcn_readfirstlane(tid >> 6);
    const int G = gridDim.x, gw = blockIdx.x * NWAVES + wave, NGW = G * NWAVES;
    unsigned char* ws = ka->ws;
    const float* w_branch_a = (const float*)ka->in[9]; const float* w_branch_b = (const float*)ka->in[10]; const float* w_out = (const float*)ka->in[13]; const float* norm_ffn = (const float*)ka->in[14];
    const float* w_peer_q = (const float*)ka->in[15]; const float* peer_u = (const float*)ka->in[17]; const float* peer_v = (const float*)ka->in[18];
    const float* swa = (const float*)(ws + WS_SWA); const float* swb = (const float*)(ws + WS_SWB); const float* swo = (const float*)(ws + WS_SWO);
    unsigned char* WCQ = ws + WS_WCQ; unsigned char* WOQ = ws + WS_WOQ; bf16* WQT = (bf16*)(ws + WS_WQT);
    unsigned char* U8 = ws + WS_U; unsigned char* V8 = ws + WS_V; float* usc = (float*)(ws + WS_USC); float* vsc = (float*)(ws + WS_VSC);
            const float q_a = 1.0f / swa[0], q_b = 1.0f / swb[0], q_o = 1.0f / swo[0];
    LAS float* scr = (LAS float*)(lds + wave * 16896);
    constexpr int I_A = (2048 / 128) * (DM / 32), I_B = (512 / 128) * (DM / 32), I_O = (DM / 128) * (DM / 32), I_Q = (DM / 128) * (QW / 32);
    for (int it = gw; it < I_A + I_B + I_O + I_Q; it += NGW) {
        int r = it;
        if (r < I_A) { transpose_tile<1>(w_branch_a, DM, WCQ, YCW, 0, 512, nullptr, q_a, scr, r, lane); continue; } r -= I_A;
        if (r < I_B) { transpose_tile<1>(w_branch_b, DM, WCQ, YCW, 0, 0, nullptr, q_b, scr, r, lane); continue; } r -= I_B;
        if (r < I_O) { transpose_tile<1>(w_out, DM, WOQ, DM, 0, 0, nullptr, q_o, scr, r, lane); continue; } r -= I_O;
        transpose_tile<0>(w_peer_q, QW, (unsigned char*)WQT, DM * 2, 0, 0, norm_ffn, 1.0f, scr, r, lane);
    }
    const int n_light = ((SEQ / 256) * (INW / 256)) % G ? G - ((SEQ / 256) * (INW / 256)) % G : 0, TBL_LATE = n_light * NWAVES * LATE_ROWS;
    conv_rows(lds, NEXP < 2 * NEXP - TBL_LATE ? NEXP : 2 * NEXP - TBL_LATE, 2 * NEXP - TBL_LATE);
}
__global__ void __launch_bounds__(NTHREADS, 2) fwd(Args args) {
    extern __shared__ __attribute__((aligned(16))) unsigned char lds_raw[];
    LAS unsigned char* lds = (LAS unsigned char*)lds_raw;
    volatile LAS unsigned* MISC = (volatile LAS unsigned*)(lds + MISC_OFF);
    const int tid = threadIdx.x, lane = tid & 63, wave = __builtin_amdgcn_readfirstlane(tid >> 6);
    const int G = gridDim.x, bid = blockIdx.x;
    const int gw = bid * NWAVES + wave, NGW = G * NWAVES;
    unsigned char* ws = args.ws;
    const float* x = (const float*)args.in[0]; const int* positions = (const int*)args.in[1]; const float* norm_mix = (const float*)args.in[2];
    const float* w_in = (const float*)args.in[3]; const float* q_norm_a = (const float*)args.in[4]; const float* k_norm_a = (const float*)args.in[5];
    const float* sinks_a = (const float*)args.in[6]; const float* q_norm_b = (const float*)args.in[7]; const float* k_norm_b = (const float*)args.in[8];
    const float* w_branch_a = (const float*)args.in[9]; const float* w_branch_b = (const float*)args.in[10]; const float* w_gate = (const float*)args.in[11];
    const float* b_gate = (const float*)args.in[12]; const float* w_out = (const float*)args.in[13]; const float* norm_ffn = (const float*)args.in[14];
    const float* w_peer_q = (const float*)args.in[15]; const float* sub_keys = (const float*)args.in[16]; const float* peer_u = (const float*)args.in[17];
    const float* peer_v = (const float*)args.in[18];
    float* out = args.out;
    float* rowf1 = (float*)(ws + WS_ROWF1); float* inv2 = (float*)(ws + WS_INV2); float* lse = (float*)(ws + WS_LSE);
    bf16* skb = (bf16*)(ws + WS_SK); float* ropec = (float*)(ws + WS_ROPE); float* ropes = (float*)(ws + WS_ROPE + 512 * 1024);
    int* experts = (int*)(ws + WS_PE); float* pgates = (float*)(ws + WS_PG);
    float* sw1 = (float*)(ws + WS_SW1); float* swa = (float*)(ws + WS_SWA); float* swb = (float*)(ws + WS_SWB); float* swo = (float*)(ws + WS_SWO);
    unsigned char* W1Q = ws + WS_W1Q; unsigned char* WCQ = ws + WS_WCQ; unsigned char* WOQ = ws + WS_WOQ; bf16* WQT = (bf16*)(ws + WS_WQT);
    unsigned char* XQ4 = ws + WS_XQ4; unsigned char* WG4 = ws + WS_WG4; float* rowf4 = (float*)(ws + WS_ROWF4);
    unsigned char* XQ = ws + WS_XQ; bf16* XB = (bf16*)(ws + WS_XB); bf16* PROJ = (bf16*)(ws + WS_PROJ); unsigned char* MERGED = ws + WS_MERGED;
    unsigned char* GATES = ws + WS_GATES; bf16* QB = (bf16*)(ws + WS_Q); unsigned char* YCAT = ws + WS_YCAT; bf16* OG = (bf16*)(ws + WS_OG);
    float* rowpart = (float*)(ws + WS_ROWPART);
    unsigned char* U8 = ws + WS_U; unsigned char* V8 = ws + WS_V; float* usc = (float*)(ws + WS_USC); float* vsc = (float*)(ws + WS_VSC);

    if (tid < 64) MISC[tid] = 0u;
    __syncthreads();
    XcdBarrier bar = xcd_barrier_post((unsigned*)(ws + WS_CTL) + CW_BAR, MISC + 8);
    const int lo = args.ph_lo, hi = args.ph_hi;
#ifndef ONLY_PHASE
#define ONLY_PHASE -1
#endif
#define IN(k) ((ONLY_PHASE < 0 || ONLY_PHASE == (k)) && lo <= (k) && (k) < hi)
#ifndef REP_PHASE
#define REP_PHASE -1
#endif
#define REPS(k) ((REP_PHASE == (k)) ? 2 : 1)
#define SEAM(k) do { if ((k) + 1 < hi || REPS(k) > 1) xcd_barrier(bar); } while (0)

    if (IN(0)) for (int rep_ = 0; rep_ < REPS(0); ++rep_) {
#ifndef P0X
#define P0X 1
#define P0W 1
#define P0T 1
#endif
        for (int rx = 0; rx < P0X; ++rx)
        for (int m = gw; m < SEQ; m += NGW) xrow_to_fp8(x + (size_t)m * DM, XQ + (size_t)m * DM, rowf1 + m, XQ4 + (size_t)m * (DM / 2), rowf4 + m, lane);
        {
            LAS float* red = (LAS float*)(lds + 8 * 16896);
            float rms_g, m_in, m_g0, m_a, m_b, m_o; wg_sample_all(w_in, w_gate, w_branch_a, w_branch_b, w_out, norm_mix, red, m_in, m_g0, rms_g, m_a, m_b, m_o);
            const float m_g = fminf(m_g0, 3.0f * rms_g) * (128.0f / 6.0f);
            const float q_in = m_in > 0.f ? 128.0f / m_in : 1.0f, q_g = m_g > 0.f ? 128.0f / m_g : 1.0f, q_a = m_a > 0.f ? 128.0f / m_a : 1.0f, q_b = m_b > 0.f ? 128.0f / m_b : 1.0f, q_o = m_o > 0.f ? 128.0f / m_o : 1.0f;
            for (int n = bid * NTHREADS + tid; n < N1 + 3 * DM; n += G * NTHREADS) {
                if (n < INW) sw1[n] = 1.0f / q_in; else if (n < N1) sw1[n] = 1.0f / q_g;
                else if (n < N1 + DM) swa[n - N1] = 1.0f / q_a; else if (n < N1 + 2 * DM) swb[n - N1 - DM] = 1.0f / q_b; else swo[n - N1 - 2 * DM] = 1.0f / q_o;
            }
            LAS float* scr = (LAS float*)(lds + wave * 16896);
            constexpr int I_IN = (DM / 128) * (INW / 32), I_G = (DM / 128) * (GATEW / 32), I_A = (2048 / 128) * (DM / 32), I_B = (512 / 128) * (DM / 32), I_O = (DM / 128) * (DM / 32), I_Q = (DM / 128) * (QW / 32);
            constexpr int NIT = I_IN + I_G + I_A + I_B + I_O + I_Q;
            (void)NIT; (void)q_a; (void)q_b; (void)q_o;
            for (int rw = 0; rw < P0W; ++rw)
            for (int it = gw; it < I_IN + I_G; it += NGW) {
                int r = it;
                if (r < I_IN) { transpose_tile<1>(w_in, INW, W1Q, DM, 0, 0, norm_mix, q_in, scr, r, lane); continue; } r -= I_IN;
                transpose_tile<2>(w_gate, GATEW, WG4, DM / 2, 0, 0, norm_mix, q_g, scr, r, lane);
            }
        }
        const int n_light = ((SEQ / 256) * (INW / 256)) % G ? G - ((SEQ / 256) * (INW / 256)) % G : 0, TBL_LATE = n_light * NWAVES * LATE_ROWS;
        (void)TBL_LATE;
        for (int i = bid * NTHREADS + tid; i < 16 * 128 * 128 / 2; i += G * NTHREADS) { const f32x2 v = *(const f32x2*)(sub_keys + 2 * (size_t)i); ((unsigned*)skb)[i] = pk2(v.x, v.y); }
        if (bid == 0) { float* gtab = (float*)(ws + WS_GTAB); gtab[tid] = tid < 128 ? q_norm_a[tid] : (tid < 256 ? k_norm_a[tid - 128] : (tid < 384 ? q_norm_b[tid - 256] : k_norm_b[tid - 384])); }
        for (int i = bid * NTHREADS + tid; i < SEQ * 16; i += G * NTHREADS) {
            const int t = i >> 4, f = i & 15;
            const float invf = expf(-13.122363377404328f * (float)f / 16.0f);
            const float ang = (float)positions[t] * invf;
            const double rev = (double)ang * 0.15915494309189535; const float fr = (float)(rev - rint(rev));
            ropec[i] = __builtin_amdgcn_cosf(fr); ropes[i] = __builtin_amdgcn_sinf(fr);
        }
        SEAM(0);
    }
    if (IN(1)) for (int rep_ = 0; rep_ < REPS(1); ++rep_) {
        {
            pg8::Gemm g{(const bf16*)XQ, (const bf16*)W1Q, SEQ, INW, DM / 2, DM / 2, DM / 2}; pg8::StaticOrder S; S.init(SEQ, INW, G, bid);
            EpiP1 E{ws, (LAS float*)(lds + 131072 + 1024)};
            pg8::gemm_phase<EpiP1, pg8::StaticOrder, true, true, 1>(lds, g, S, E);
        }
        {
            pg8::Gemm g{(const bf16*)XQ4, (const bf16*)WG4, SEQ, GATEW, DM / 4, DM / 4, DM / 4}; pg8::StaticOrder S; S.init(SEQ, GATEW, G, bid);
            EpiG4 E{ws, b_gate};
            pg8::gemm_phase<EpiG4, pg8::StaticOrder, true, true, 2>(lds, g, S, E);
        }
        {
            const int n_heavy = ((SEQ / 256) * (INW / 256)) % G, n_light = n_heavy ? G - n_heavy : 0, TBL_LATE = n_light * NWAVES * LATE_ROWS;
            if (n_light && bid >= n_heavy) {
                const int lw = (bid - n_heavy) * NWAVES + wave;
#pragma unroll 1
                for (int j = 0; j < LATE_ROWS; ++j) { const int m = 2 * NEXP - TBL_LATE + j * (n_light * NWAVES) + lw;
                    if (m < NEXP) row_to_fp4(peer_u + (size_t)m * DM, U8 + (size_t)m * ROW4, usc + m, lane);
                    else row_to_fp4(peer_v + (size_t)(m - NEXP) * DM, V8 + (size_t)(m - NEXP) * ROW4, vsc + (m - NEXP), lane); }
            }
        }
        SEAM(1);
    }
    if (IN(2)) for (int rep_ = 0; rep_ < REPS(2); ++rep_) {
        const bool conv_first = ((bid >> 3) & 1) == 0;
        if (conv_first) { conv_job(lds); __syncthreads(); }
        attention_phase(lds, PROJ, sinks_a, YCAT, OG, lse, bid, G);
        if (!conv_first) { __syncthreads(); conv_job(lds); }
        SEAM(2);
    }
    if (IN(3)) for (int rep_ = 0; rep_ < REPS(3); ++rep_) { combine_phase(OG, lse, YCAT, bid * NTHREADS + tid, G * NTHREADS); SEAM(3); }
    if (IN(4)) for (int rep_ = 0; rep_ < REPS(4); ++rep_) {
        pg8::Gemm g{(const bf16*)YCAT, (const bf16*)WCQ, SEQ, DM, YCW / 2, YCW / 2, YCW / 2}; pg8::StaticOrder S; S.init(SEQ, DM, G, bid);
        EpiMerge E{GATES, MERGED, swa, swb};
        pg8::gemm_phase<EpiMerge, pg8::StaticOrder, true, true, true>(lds, g, S, E);
        SEAM(4);
    }
    if (IN(5)) for (int rep_ = 0; rep_ < REPS(5); ++rep_) {
        const bool rows_first = ((bid >> 3) & 1) != 0;
        if (rows_first) { conv_rows(lds, 0, NEXP); __syncthreads(); }
        pg8::Gemm g{(const bf16*)MERGED, (const bf16*)WOQ, SEQ, DM, DM / 2, DM / 2, DM / 2}; pg8::StaticOrder S; S.init(SEQ, DM, G, bid);
        EpiOut E{x, out, swo, XB, rowpart};
        pg8::gemm_phase<EpiOut, pg8::StaticOrder, true, true, true>(lds, g, S, E);
        if (!rows_first) { __syncthreads(); conv_rows(lds, 0, NEXP); }
        SEAM(5);
    }
    if (IN(6)) for (int rep_ = 0; rep_ < REPS(6); ++rep_) {
        pg8::Gemm g{XB, WQT, SEQ, QW, DM, DM, DM}; pg8::StaticOrder S; S.init(SEQ, QW, G, bid);
        LAS float* inv2l = (LAS float*)(lds + 131072);
        pg8::Unit u0;
        if (S.next(0, u0)) {
            const int rl = tid >> 1, hf = tid & 1; const float* rp = rowpart + (size_t)(u0.pm * 256 + rl) * 64 + hf * 32;
            float s = 0.f;
#pragma unroll
            for (int j = 0; j < 8; ++j) { const f32x4 v = *(const f32x4*)(rp + 4 * j); s += (v.x + v.y) + (v.z + v.w); }
            s += __shfl_xor(s, 1);
            const float iv = 1.0f / sqrtf(s * (1.0f / DM) + EPS);
            if (hf == 0) { inv2l[rl] = iv; if (u0.pn == 0) inv2[u0.pm * 256 + rl] = iv; }
        }
        __syncthreads();
        EpiQ E{QB, inv2l};
        pg8::gemm_phase<EpiQ, pg8::StaticOrder, true, true, false>(lds, g, S, E);
        SEAM(6);
    }
    if (IN(7)) for (int rep_ = 0; rep_ < REPS(7); ++rep_) {
        for (int tb = bid; tb < SEQ / 32; tb += G) {
            routing_block(lds, QB, skb, experts, pgates, tb);
            asm volatile("s_waitcnt vmcnt(0)" ::: "memory");
            __syncthreads();
#pragma unroll 1
            for (int j = 0; j < 4; ++j) { const int t = tb * 32 + wave * 4 + j;
                peer_token(lds + wave * (4 * RSLOT), XB + (size_t)t * DM, inv2[t], norm_ffn, experts + (size_t)t * 128, pgates + (size_t)t * 128, U8, V8, usc, vsc, out + (size_t)t * DM, lane); }
            __syncthreads();
        }
    }
#undef IN
#undef SEAM
}

extern "C" void kernel_launch(void* const* d_in, const int* in_sizes, int n_in, void* d_out, int out_size, void* d_ws, size_t ws_size, hipStream_t stream) {
    static int grid = 0;
    if (grid == 0) {
        if (n_in != 19 || out_size != SEQ * DM || ws_size < WS_END) { fprintf(stderr, "kernel_launch: unexpected shapes (n_in %d, out %d, ws %zu); nothing launched\n", n_in, out_size, ws_size); grid = -1; return; }
        int dev = 0, cus = 0, per_cu = 0;
        if (hipGetDevice(&dev) != hipSuccess || hipDeviceGetAttribute(&cus, hipDeviceAttributeMultiprocessorCount, dev) != hipSuccess) { grid = -1; return; }
        if (hipFuncSetAttribute((const void*)fwd, hipFuncAttributeMaxDynamicSharedMemorySize, LDS_BYTES) != hipSuccess) { fprintf(stderr, "kernel_launch: hipFuncSetAttribute failed\n"); grid = -1; return; }
        if (hipOccupancyMaxActiveBlocksPerMultiprocessor(&per_cu, (const void*)fwd, NTHREADS, LDS_BYTES) != hipSuccess || per_cu < 1) { fprintf(stderr, "kernel_launch: occupancy query says %d\n", per_cu); (void)hipGetLastError(); grid = -1; return; }
        grid = cus;
    }
    if (grid < 0) return;
    (void)hipMemsetAsync((char*)d_ws + WS_CTL, 0, CTL_ZERO_BYTES, stream);
    Args a{};
    for (int i = 0; i < 19; ++i) a.in[i] = d_in[i];
    a.out = (float*)d_out; a.ws = (unsigned char*)d_ws;
#if MK_N_LAUNCHES == 1
    a.ph_lo = 0; a.ph_hi = NPHASES;
    hipLaunchKernelGGL(fwd, dim3(grid), dim3(NTHREADS), LDS_BYTES, stream, a);
#else
#ifndef TWICE_PHASE
#define TWICE_PHASE -1
#endif
    for (int p = 0; p < NPHASES; ++p) { a.ph_lo = p; a.ph_hi = p + 1; hipLaunchKernelGGL(fwd, dim3(grid), dim3(NTHREADS), LDS_BYTES, stream, a);
        if (p == TWICE_PHASE) hipLaunchKernelGGL(fwd, dim3(grid), dim3(NTHREADS), LDS_BYTES, stream, a);
        if (TWICE_PHASE == 99 && p == NPHASES - 1) { for (int p2 = 0; p2 < NPHASES; ++p2) { a.ph_lo = p2; a.ph_hi = p2 + 1; hipLaunchKernelGGL(fwd, dim3(grid), dim3(NTHREADS), LDS_BYTES, stream, a); } }
        if (TWICE_PHASE == 23 && p == 3) { a.ph_lo = 2; a.ph_hi = 3; hipLaunchKernelGGL(fwd, dim3(grid), dim3(NTHREADS), LDS_BYTES, stream, a); a.ph_lo = 3; a.ph_hi = 4; hipLaunchKernelGGL(fwd, dim3(grid), dim3(NTHREADS), LDS_BYTES, stream, a); } }
#endif
}
```

```cpp
#include <hip/hip_runtime.h>
#include <cstdio>
#include <cstdint>

#ifndef MK_N_LAUNCHES
#define MK_N_LAUNCHES 1
#endif

namespace pg8 {
#define PG8_LAS __attribute__((address_space(3)))
typedef unsigned short bf16_t;
typedef short bf16x8 __attribute__((ext_vector_type(8)));
typedef float f32x4 __attribute__((ext_vector_type(4)));
typedef unsigned u32x4 __attribute__((ext_vector_type(4)));
typedef int i32x4 __attribute__((ext_vector_type(4)));
typedef int i32x8 __attribute__((ext_vector_type(8)));
constexpr int BM = 256, BK = 64, HALF = 128, HTB = HALF * BK * 2  , STAGE_BYTES = 8 * HTB, NXCD = 8, WGM = 8;

__host__ __device__ __forceinline__ int lds_byte(int r, int c) { const int st = (r >> 4) * 2 + (c >> 5), rr = r & 15, cc = c & 31, ob = rr * 64 + cc * 2; return st * 1024 + (ob ^ (((ob >> 9) & 1) << 5)); }
__host__ __device__ __forceinline__ void stage_rc(int b, int& R, int& C) { const int st = b / 1024, sb = b % 1024, swz = sb ^ (((sb >> 9) & 1) << 5); R = (st >> 1) * 16 + swz / 64; C = (st & 1) * 32 + (swz % 64) / 2; }
__host__ __device__ __forceinline__ int perm32(int rho) { const int n = rho >> 4, i = rho & 15; return 8 * (i >> 2) + 4 * n + (i & 3); }

struct Unit { int pm, pn; };
struct Gemm { const bf16_t* A; const bf16_t* Bt; int M, N, K, lda, ldb; };

struct StaticOrder {
    int nM, nN, nwg, G, c;
    __host__ __device__ void init(int M, int N, int G_, int c_) { nM = M / BM; nN = N / BM; nwg = nM * nN; G = G_; c = c_; }
    __host__ __device__ bool next(int i, Unit& u) const {
        const long L = (long)i * G + c; if (L >= nwg) return false;
        int wgid = (int)L; { const int q = nwg / NXCD, r = nwg % NXCD, xcd = wgid % NXCD, off = wgid / NXCD; wgid = (xcd < r ? xcd * (q + 1) : r * (q + 1) + (xcd - r) * q) + off; }
        const int nig = WGM * nN, gid = wgid / nig, fm = gid * WGM, gsz = (nM - fm) < WGM ? (nM - fm) : WGM;
        u.pm = fm + ((wgid % nig) % gsz); u.pn = (wgid % nig) / gsz; return true;
    }
    __device__ __forceinline__ void a_ready(const Unit&) const {}
    __device__ __forceinline__ void done(const Unit&) const {}
};

__device__ __forceinline__ unsigned cvt_pk_bf16(float lo, float hi) { unsigned r; asm volatile("v_cvt_pk_bf16_f32 %0, %1, %2" : "=v"(r) : "v"(lo), "v"(hi)); return r; }

template <class Epi, class Sched, bool ALIGN_EPI = false, bool SP2 = false, int FP8 = 0  >
__device__ __forceinline__ void gemm_phase(PG8_LAS unsigned char* lds, const Gemm g, const Sched& S, const Epi& E) {
    const int tid = threadIdx.x, wid = __builtin_amdgcn_readfirstlane(tid >> 6), lane = tid & 63, wr = wid >> 2, wc = wid & 3, fr = lane & 15, fq = lane >> 4;
    const int K = g.K, nt = K / BK;
    unsigned voffA[2], voffB[2];
#pragma unroll
    for (int i = 0; i < 2; ++i) { int R, C; stage_rc(tid * 16 + i * 8192, R, C); const int Rb = Epi::PERM ? ((R & ~31) + perm32(R & 31)) : R;
        voffA[i] = (unsigned)(R * g.lda + C) * 2u; voffB[i] = (unsigned)(Rb * g.ldb + C) * 2u; }
    const size_t kstep = (size_t)(BK * 2);
    const size_t hstepA = (size_t)HALF * g.lda * 2, hstepB = (size_t)HALF * g.ldb * 2;
    const size_t tstepA = 2 * hstepA, tstepB = 2 * hstepB;
    const unsigned ldsw = (unsigned)wid * 1024u;
    const int aoff = lds_byte(wr * 64 + fr, fq * 8), boff = lds_byte(wc * 32 + fr, fq * 8);
#define PG8_SA(b, h) (((b) * 2 + (h)) * HTB)
#define PG8_SB(b, h) ((4 + (b) * 2 + (h)) * HTB)
#define PG8_STAGE(bufoff, gbase, voff) do { _Pragma("unroll") for (int _i = 0; _i < 2; ++_i) \
        __builtin_amdgcn_global_load_lds((const unsigned*)((const char*)(gbase) + (voff)[_i]), (PG8_LAS unsigned*)(lds + (bufoff) + ldsw + _i * 8192), 16, 0, 0); } while (0)
#define PG8_LDA(dst, b, h) do { _Pragma("unroll") for (int m = 0; m < 4; ++m) _Pragma("unroll") for (int k = 0; k < 2; ++k) dst[m][k] = *(const PG8_LAS bf16x8*)(lds + PG8_SA(b, h) + aoff + m * 2048 + k * 1024); } while (0)
#define PG8_LDB(dst, b, h) do { _Pragma("unroll") for (int n = 0; n < 2; ++n) _Pragma("unroll") for (int k = 0; k < 2; ++k) dst[n][k] = *(const PG8_LAS bf16x8*)(lds + PG8_SB(b, h) + boff + n * 2048 + k * 1024); } while (0)
#define PG8_CAT(x0, x1) __builtin_shufflevector(__builtin_bit_cast(i32x4, x0), __builtin_bit_cast(i32x4, x1), 0, 1, 2, 3, 4, 5, 6, 7)
#define PG8_MMA(ai, bj, At, Bt) do { __builtin_amdgcn_s_setprio(1); \
        if constexpr (FP8 == 2) { _Pragma("unroll") for (int m = 0; m < 4; ++m) _Pragma("unroll") for (int n = 0; n < 2; ++n) _Pragma("unroll") for (int k = 0; k < 2; ++k) \
            asm volatile("v_mfma_scale_f32_16x16x128_f8f6f4 %0, %1, %2, %0, %3, %3 op_sel_hi:[0,0,0] cbsz:4 blgp:4" : "+v"(acc[ai][bj][m][n]) : "v"(__builtin_bit_cast(i32x4, Bt[n][k])), "v"(__builtin_bit_cast(i32x4, At[m][k])), "v"(one_scale)); } \
        else if constexpr (FP8 == 1) { _Pragma("unroll") for (int m = 0; m < 4; ++m) _Pragma("unroll") for (int n = 0; n < 2; ++n) \
            asm volatile("v_mfma_scale_f32_16x16x128_f8f6f4 %0, %1, %2, %0, %3, %3 op_sel_hi:[0,0,0]" : "+v"(acc[ai][bj][m][n]) : "v"(PG8_CAT(Bt[n][0], Bt[n][1])), "v"(PG8_CAT(At[m][0], At[m][1])), "v"(one_scale)); } \
        else { _Pragma("unroll") for (int m = 0; m < 4; ++m) _Pragma("unroll") for (int n = 0; n < 2; ++n) _Pragma("unroll") for (int k = 0; k < 2; ++k) \
            acc[ai][bj][m][n] = __builtin_amdgcn_mfma_f32_16x16x32_bf16(Bt[n][k], At[m][k], acc[ai][bj][m][n], 0, 0, 0); } \
        __builtin_amdgcn_s_setprio(0); } while (0)
#define PG8_WAIT_V(n) asm volatile("s_waitcnt vmcnt(" #n ")" ::: "memory")
#define PG8_WAIT_L(n) asm volatile("s_waitcnt lgkmcnt(" #n ")" ::: "memory")
#define PG8_BAR __builtin_amdgcn_s_barrier()
#define PG8_SCHED __builtin_amdgcn_sched_barrier(0)
    Unit cur, nxt; int ui = 0;
    if (!S.next(0, cur)) return;
    const int one_scale = 0x7F7F7F7F;
    f32x4 acc[2][2][4][2];
#pragma unroll
    for (int a = 0; a < 2; ++a)
#pragma unroll
        for (int b = 0; b < 2; ++b)
#pragma unroll
            for (int m = 0; m < 4; ++m)
#pragma unroll
                for (int n = 0; n < 2; ++n) acc[a][b][m][n] = (f32x4){0.f, 0.f, 0.f, 0.f};
    bf16x8 At[4][2], B0[2][2], B1[2][2];
    const char* cA = (const char*)g.A + (size_t)cur.pm * tstepA; const char* cB = (const char*)g.Bt + (size_t)cur.pn * tstepB;
    S.a_ready(cur);
    if constexpr (SP2) {
        PG8_STAGE(PG8_SB(0, 0), cB, voffB); PG8_STAGE(PG8_SB(0, 1), cB + hstepB, voffB); PG8_STAGE(PG8_SA(0, 0), cA, voffA); PG8_STAGE(PG8_SA(0, 1), cA + hstepA, voffA);
        if (wr == 1) PG8_BAR;
        PG8_WAIT_V(2); PG8_BAR;
        PG8_STAGE(PG8_SB(1, 0), cB + kstep, voffB); PG8_STAGE(PG8_SA(1, 0), cA + kstep, voffA); PG8_STAGE(PG8_SB(1, 1), cB + hstepB + kstep, voffB);
        PG8_WAIT_V(6); PG8_BAR;
    } else {
        PG8_STAGE(PG8_SB(0, 0), cB, voffB); PG8_STAGE(PG8_SA(0, 0), cA, voffA); PG8_STAGE(PG8_SB(0, 1), cB + hstepB, voffB); PG8_STAGE(PG8_SA(0, 1), cA + hstepA, voffA);
        if (wr == 1) PG8_BAR;
        PG8_WAIT_V(4); PG8_BAR;
        PG8_STAGE(PG8_SB(1, 0), cB + kstep, voffB); PG8_STAGE(PG8_SA(1, 0), cA + kstep, voffA); PG8_STAGE(PG8_SB(1, 1), cB + hstepB + kstep, voffB);
        PG8_WAIT_V(6); PG8_BAR;
    }
    for (;;) {
        const bool has_next = S.next(ui + 1, nxt);
        const char* nA = has_next ? (const char*)g.A + (size_t)nxt.pm * tstepA : cA; const char* nB = has_next ? (const char*)g.Bt + (size_t)nxt.pn * tstepB : cB;
#pragma unroll 1
        for (int t = 0; t < nt; t += 2) {
            const bool last = (t == nt - 2);
            const char* a1 = cA + (size_t)(t + 1) * kstep;
            const char* a2 = last ? nA : cA + (size_t)(t + 2) * kstep; const char* b2 = last ? nB : cB + (size_t)(t + 2) * kstep;
            const char* a3 = a2 + kstep; const char* b3 = b2 + kstep;
            if (last && has_next) S.a_ready(nxt);
            if constexpr (Epi::MIDK > 0) { if (t == Epi::MIDK) {
                if constexpr (FP8) asm volatile("s_nop 15\n\ts_nop 15" ::: "memory");
                E.mid(acc, cur, wr, wc, fr, fq);
                if constexpr (FP8) asm volatile("s_nop 7" ::: "memory"); } }
            if constexpr (SP2) {
            PG8_LDB(B0, 0, 0); PG8_LDB(B1, 0, 1); PG8_SCHED; PG8_LDA(At, 0, 0); PG8_STAGE(PG8_SA(1, 1), a1 + hstepA, voffA);
            PG8_WAIT_V(8); PG8_WAIT_L(0); PG8_BAR; PG8_MMA(0, 0, At, B0); PG8_MMA(0, 1, At, B1); PG8_BAR; PG8_SCHED;
            PG8_LDA(At, 0, 1); PG8_STAGE(PG8_SB(0, 0), b2, voffB); PG8_STAGE(PG8_SB(0, 1), b2 + hstepB, voffB); PG8_STAGE(PG8_SA(0, 0), a2, voffA);
            PG8_WAIT_V(8); PG8_WAIT_L(0); PG8_BAR; PG8_MMA(1, 0, At, B0); PG8_MMA(1, 1, At, B1); PG8_BAR; PG8_SCHED;
            PG8_LDB(B0, 1, 0); PG8_LDB(B1, 1, 1); PG8_SCHED; PG8_LDA(At, 1, 0); PG8_STAGE(PG8_SA(0, 1), a2 + hstepA, voffA);
            PG8_WAIT_V(8); PG8_WAIT_L(0); PG8_BAR; PG8_MMA(0, 0, At, B0); PG8_MMA(0, 1, At, B1); PG8_BAR; PG8_SCHED;
            PG8_LDA(At, 1, 1); PG8_STAGE(PG8_SB(1, 0), b3, voffB); PG8_STAGE(PG8_SB(1, 1), b3 + hstepB, voffB); PG8_STAGE(PG8_SA(1, 0), a3, voffA);
            PG8_WAIT_V(8); PG8_WAIT_L(0); PG8_BAR; PG8_MMA(1, 0, At, B0); PG8_MMA(1, 1, At, B1); PG8_BAR; PG8_SCHED;
            } else {
            PG8_LDB(B0, 0, 0); PG8_SCHED; PG8_LDA(At, 0, 0); PG8_STAGE(PG8_SA(1, 1), a1 + hstepA, voffA);
            PG8_WAIT_L(8); PG8_BAR; PG8_WAIT_L(0); PG8_MMA(0, 0, At, B0); PG8_BAR; PG8_SCHED;
            PG8_LDB(B1, 0, 1); PG8_STAGE(PG8_SB(0, 0), b2, voffB);
            PG8_BAR; PG8_WAIT_L(0); PG8_MMA(0, 1, At, B1); PG8_BAR;
            PG8_LDA(At, 0, 1); PG8_STAGE(PG8_SA(0, 0), a2, voffA);
            PG8_BAR; PG8_WAIT_L(0); PG8_MMA(1, 0, At, B0); PG8_BAR; PG8_SCHED;
            PG8_STAGE(PG8_SB(0, 1), b2 + hstepB, voffB);
            PG8_WAIT_V(6); PG8_BAR; PG8_MMA(1, 1, At, B1); PG8_BAR;
            PG8_LDB(B0, 1, 0); PG8_SCHED; PG8_LDA(At, 1, 0); PG8_STAGE(PG8_SA(0, 1), a2 + hstepA, voffA);
            PG8_WAIT_L(8); PG8_BAR; PG8_WAIT_L(0); PG8_MMA(0, 0, At, B0); PG8_BAR; PG8_SCHED;
            PG8_LDB(B1, 1, 1); PG8_STAGE(PG8_SB(1, 0), b3, voffB);
            PG8_BAR; PG8_WAIT_L(0); PG8_MMA(0, 1, At, B1); PG8_BAR;
            PG8_LDA(At, 1, 1); PG8_STAGE(PG8_SA(1, 0), a3, voffA);
            PG8_BAR; PG8_WAIT_L(0); PG8_MMA(1, 0, At, B0); PG8_BAR; PG8_SCHED;
            PG8_STAGE(PG8_SB(1, 1), b3 + hstepB, voffB);
            PG8_WAIT_V(6); PG8_BAR; PG8_MMA(1, 1, At, B1); PG8_BAR;
            }
        }
        if constexpr (ALIGN_EPI) { if (wr == 0) PG8_BAR; }
        if constexpr (FP8) asm volatile("s_nop 15\n\ts_nop 15" ::: "memory");
        E(acc, cur, wr, wc, fr, fq); S.done(cur);
        if (!has_next) break;
#pragma unroll
        for (int a = 0; a < 2; ++a)
#pragma unroll
            for (int b = 0; b < 2; ++b)
#pragma unroll
                for (int m = 0; m < 4; ++m)
#pragma unroll
                    for (int n = 0; n < 2; ++n) acc[a][b][m][n] = (f32x4){0.f, 0.f, 0.f, 0.f};
        cur = nxt; cA = nA; cB = nB; ++ui;
        if constexpr (ALIGN_EPI) { if (wr == 1) PG8_BAR; }
    }
    PG8_WAIT_V(0);
    if constexpr (!ALIGN_EPI) { if (wr == 0) PG8_BAR; }
    PG8_BAR;
#undef PG8_SA
#undef PG8_SB
#undef PG8_STAGE
#undef PG8_LDA
#undef PG8_LDB
#undef PG8_MMA
#undef PG8_CAT
#undef PG8_WAIT_V
#undef PG8_WAIT_L
#undef PG8_BAR
#undef PG8_SCHED
}
}

constexpr int SEQ = 8192, DM = 4096, HD = 128;
constexpr int INW = 7680, GATEW = 8192, N1 = INW + GATEW;
constexpr int YCW = 2560;
constexpr int QW = 2048;
constexpr int NEXP = 16384;
constexpr int COL_QA = 0, COL_KA = 2048, COL_VA = 2560, COL_QB = 3072, COL_KB = 4608, COL_VB = 6144;
constexpr float EPS = 1e-6f;
constexpr int NWAVES = 8, NTHREADS = 512;
constexpr int NPHASES = 8;

constexpr size_t MiB = 1u << 20;
constexpr size_t WS_CTL = 0, CTL_ZERO_BYTES = 64 * 1024;
constexpr size_t WS_INV1 = 1 * MiB, WS_INV2 = 1 * MiB + 64 * 1024, WS_LSE = 1 * MiB + 128 * 1024;
constexpr size_t WS_SK = 1 * MiB + 512 * 1024;
constexpr size_t WS_ROPE = 2 * MiB;
constexpr size_t WS_PE = 4 * MiB, WS_PG = 8 * MiB;
constexpr size_t WS_ROWF1 = 1 * MiB;
constexpr size_t WS_SW1 = 12 * MiB + 128 * 1024;
constexpr size_t WS_SWA = 12 * MiB + 192 * 1024, WS_SWB = 12 * MiB + 208 * 1024, WS_SWO = 12 * MiB + 224 * 1024;
constexpr size_t WS_W1Q = 16 * MiB;
constexpr size_t WS_WCQ = 80 * MiB;
constexpr size_t WS_WOQ = 92 * MiB;
constexpr size_t WS_WQT = 108 * MiB;
constexpr size_t WS_XQ = 124 * MiB;
constexpr size_t WS_XB = 156 * MiB;
constexpr size_t WS_PROJ = 220 * MiB;
constexpr size_t WS_MERGED = 220 * MiB;
constexpr size_t WS_GATES = 340 * MiB;
constexpr size_t WS_Q = 340 * MiB;
constexpr size_t WS_YCAT = 468 * MiB;
constexpr size_t WS_OG = 488 * MiB;
constexpr size_t WS_U = 512 * MiB, WS_V = 576 * MiB;
constexpr size_t WS_USC = 12 * MiB, WS_VSC = 12 * MiB + 64 * 1024;
constexpr size_t WS_XQ4 = 640 * MiB;
constexpr size_t WS_WG4 = 656 * MiB;
constexpr size_t WS_GTAB = 12 * MiB + 256 * 1024;
constexpr size_t WS_ROWF4 = 12 * MiB + 320 * 1024;
constexpr size_t WS_ROWPART = 13 * MiB;
constexpr size_t WS_END = 672 * MiB;
constexpr float YSCALE = 64.0f, MSCALE = 128.0f;

constexpr int CW_BAR = 4096;
constexpr int LDS_BYTES = 147456;
constexpr int MISC_OFF = 147456 - 256;

#define GAS __attribute__((address_space(1)))
#define LAS __attribute__((address_space(3)))
typedef unsigned short bf16;
typedef unsigned v4u __attribute__((ext_vector_type(4)));
typedef unsigned v2u __attribute__((ext_vector_type(2)));
typedef float f32x4 __attribute__((ext_vector_type(4)));
typedef float f32x2 __attribute__((ext_vector_type(2)));
typedef float f32x16 __attribute__((ext_vector_type(16)));
typedef short bf16x8 __attribute__((ext_vector_type(8)));
typedef short s16x4 __attribute__((ext_vector_type(4)));
typedef __bf16 bfv2 __attribute__((ext_vector_type(2)));
#define DI __device__ __forceinline__

DI unsigned pk2(float lo, float hi) { f32x2 v = {lo, hi}; return __builtin_bit_cast(unsigned, __builtin_convertvector(v, bfv2)); }
DI float bflo(unsigned w) { return __builtin_bit_cast(float, w << 16); }
DI float bfhi(unsigned w) { return __builtin_bit_cast(float, w & 0xffff0000u); }
DI float wave_sum(float v) {
#pragma unroll
    for (int o = 1; o < 64; o <<= 1) v += __shfl_xor(v, o);
    return v;
}

#define XB_TMO      128
#define XB_XCNT(j)  (256  + 64 * (j))
#define XB_XSUB(j)  (1280 + 64 * (j))
#define XB_XGEN(j)  (2304 + 64 * (j))
#define XB_TOP      3328
#define XB_TOPGEN   3392
#define XCD_BAR_WORDS 3456
#define XB_SPIN_CAP (1u << 22)

__device__ __forceinline__ unsigned xb_ld(unsigned* p)              { return __hip_atomic_load(p, __ATOMIC_RELAXED, __HIP_MEMORY_SCOPE_AGENT); }
__device__ __forceinline__ unsigned xb_add(unsigned* p, unsigned v) { return __hip_atomic_fetch_add(p, v, __ATOMIC_RELAXED, __HIP_MEMORY_SCOPE_AGENT); }
__device__ __forceinline__ unsigned xb_xcc_id() { return (unsigned)__builtin_amdgcn_s_getreg((3 << 11) | 20) & 0xFu; }
#define XB_SPIN(cond, bar) do { unsigned _sp = 0; while (cond) { __builtin_amdgcn_s_sleep(1); \
    if ((++_sp & 255u) == 0u) { if (xb_ld(&(bar)[XB_TMO])) break; if (_sp > XB_SPIN_CAP) { atomicAdd(&(bar)[XB_TMO], 1u); break; } } } } while (0)

struct XcdBarrier { unsigned* bar; unsigned x; volatile LAS unsigned* st; };

__device__ __forceinline__ XcdBarrier xcd_barrier_post(unsigned* bar, volatile LAS unsigned* st) {
    XcdBarrier b; b.bar = bar; b.x = xb_xcc_id(); b.st = st;
    if (threadIdx.x == 0) (void)xb_add(&bar[XB_XCNT(b.x)], 1u);
    return b;
}
__device__ __forceinline__ void xcd_barrier_complete(unsigned* bar, unsigned x, unsigned& nloc, unsigned& nx) {
    const unsigned G = gridDim.x * gridDim.y * gridDim.z;
    unsigned sum, cnt, mine, sp = 0u;
    for (;;) {
        sum = 0u; cnt = 0u; mine = 0u;
#pragma unroll
        for (unsigned j = 0; j < 16; ++j) { const unsigned c = xb_ld(&bar[XB_XCNT(j)]); sum += c; cnt += (c > 0u) ? 1u : 0u; mine = (j == x) ? c : mine; }
        if (sum == G) break;
        __builtin_amdgcn_s_sleep(1);
        if ((++sp & 255u) == 0u) { if (xb_ld(&bar[XB_TMO])) break; if (sp > XB_SPIN_CAP) { atomicAdd(&bar[XB_TMO], 1u); break; } }
    }
    nloc = mine > 0u ? mine : 1u; nx = cnt > 0u ? cnt : 1u;
}
__device__ __forceinline__ void xcd_barrier(const XcdBarrier& b) {
    asm volatile("s_waitcnt vmcnt(0)" ::: "memory");
    __syncthreads();
    if (threadIdx.x == 0) {
        unsigned* bar = b.bar;
        __builtin_amdgcn_s_waitcnt(0);
        unsigned nloc = b.st[0], nx = b.st[1];
        if (nloc == 0u) { xcd_barrier_complete(bar, b.x, nloc, nx); b.st[0] = nloc; b.st[1] = nx; }
        const unsigned old = xb_add(&bar[XB_XSUB(b.x)], 1u);
        const unsigned gen = old / nloc;
        if (old + 1u == (gen + 1u) * nloc) {
            __builtin_amdgcn_fence(__ATOMIC_RELEASE, "agent");
            asm volatile("s_waitcnt vmcnt(0)" ::: "memory");
            const unsigned og = xb_add(&bar[XB_TOP], 1u);
            const unsigned tg = og / nx;
            if (og + 1u == (tg + 1u) * nx) xb_add(&bar[XB_TOPGEN], 1u);
            else XB_SPIN(xb_ld(&bar[XB_TOPGEN]) == tg, bar);
            __builtin_amdgcn_fence(__ATOMIC_ACQUIRE, "agent");
            xb_add(&bar[XB_XGEN(b.x)], 1u);
            asm volatile("s_waitcnt vmcnt(0)" ::: "memory");
        } else {
            XB_SPIN(xb_ld(&bar[XB_XGEN(b.x)]) == gen, bar);
            __builtin_amdgcn_fence(__ATOMIC_ACQUIRE, "agent");
            asm volatile("s_waitcnt vmcnt(0)" ::: "memory");
        }
    }
    __syncthreads();
}

DI void unp8_fp8(v2u w, float (&f)[8]) {
    const f32x2 a = __builtin_amdgcn_cvt_pk_f32_fp8((int)w.x, false), b = __builtin_amdgcn_cvt_pk_f32_fp8((int)w.x, true), c = __builtin_amdgcn_cvt_pk_f32_fp8((int)w.y, false), d = __builtin_amdgcn_cvt_pk_f32_fp8((int)w.y, true);
    f[0] = a.x; f[1] = a.y; f[2] = b.x; f[3] = b.y; f[4] = c.x; f[5] = c.y; f[6] = d.x; f[7] = d.y;
}
DI unsigned pk4_fp8(float a, float b, float c, float d) {
    a = fminf(fmaxf(a, -448.f), 448.f); b = fminf(fmaxf(b, -448.f), 448.f); c = fminf(fmaxf(c, -448.f), 448.f); d = fminf(fmaxf(d, -448.f), 448.f);
    int p = __builtin_amdgcn_cvt_pk_fp8_f32(a, b, 0, false); p = __builtin_amdgcn_cvt_pk_fp8_f32(c, d, p, true); return (unsigned)p;
}

struct EpiP1 {
    static constexpr bool PERM = true; static constexpr int MIDK = 0;
    unsigned char* ws; LAS float* red;
    DI void operator()(const pg8::f32x4 (&acc)[2][2][4][2], const pg8::Unit& u, int wr, int wc, int fr, int fq) const {
        asm volatile("" : "+v"(fr), "+v"(fq));
        bf16* proj = (bf16*)(ws + WS_PROJ); unsigned char* gates = ws + WS_GATES; const float* inv1 = (const float*)(ws + WS_ROWF1); const float* sw = (const float*)(ws + WS_SW1);
        const float* ropec = (const float*)(ws + WS_ROPE); const float* ropes = ropec + SEQ * 16; const float* gtab = (const float*)(ws + WS_GTAB);
        const int row0 = u.pm * 256 + wr * 64 + fr, col0 = u.pn * 256 + wc * 32 + 8 * fq;
        const int pn = u.pn;
        const bool normed = (pn < 10) || (pn >= 12 && pn < 24);
        const float* gain = gtab + (pn < 8 ? 0 : (pn < 10 ? 128 : (pn < 18 ? 256 : 384)));
        const float cw = sw[0];
        if (!normed) {
#pragma unroll
            for (int ai = 0; ai < 2; ++ai)
#pragma unroll
                for (int m = 0; m < 4; ++m) {
                    const int row = row0 + ai * 128 + m * 16; const float s = inv1[row] * cw;
#pragma unroll
                    for (int bj = 0; bj < 2; ++bj) {
                        const f32x4 v0 = acc[ai][bj][m][0] * s, v1 = acc[ai][bj][m][1] * s;
                        v4u w; w.x = pk2(v0[0], v0[1]); w.y = pk2(v0[2], v0[3]); w.z = pk2(v1[0], v1[1]); w.w = pk2(v1[2], v1[3]);
                        *(v4u*)(proj + (size_t)row * INW + col0 + bj * 128) = w;
                    }
                }
            return;
        }
        float sv[2][4];
#pragma unroll
        for (int ai = 0; ai < 2; ++ai)
#pragma unroll
            for (int m = 0; m < 4; ++m) sv[ai][m] = inv1[u.pm * 256 + ai * 128 + wr * 64 + m * 16 + fr] * cw;
#pragma unroll
        for (int ai = 0; ai < 2; ++ai)
#pragma unroll
            for (int m = 0; m < 4; ++m) {
                const int rl = ai * 128 + wr * 64 + m * 16 + fr; const float s = sv[ai][m];
#pragma unroll
                for (int bj = 0; bj < 2; ++bj) {
                    const f32x4 v0 = acc[ai][bj][m][0], v1 = acc[ai][bj][m][1];
                    float ss = ((v0[0] * v0[0] + v0[1] * v0[1]) + (v0[2] * v0[2] + v0[3] * v0[3]) + (v1[0] * v1[0] + v1[1] * v1[1]) + (v1[2] * v1[2] + v1[3] * v1[3])) * (s * s);
                    ss += __shfl_xor(ss, 16); ss += __shfl_xor(ss, 32);
                    if (fq == 0) red[(rl * 2 + bj) * 4 + wc] = ss;
                }
            }
        asm volatile("s_waitcnt lgkmcnt(0)" ::: "memory"); __builtin_amdgcn_s_barrier(); asm volatile("" ::: "memory");
        const f32x4 g0 = *(const f32x4*)(gain + wc * 32 + 8 * fq), g1 = *(const f32x4*)(gain + wc * 32 + 8 * fq + 4);
#pragma unroll
        for (int ai = 0; ai < 2; ++ai)
#pragma unroll
            for (int m = 0; m < 4; ++m) {
                const int rl = ai * 128 + wr * 64 + m * 16 + fr, row = u.pm * 256 + rl; const float s = sv[ai][m];
                f32x4 cs0 = {1.f, 1.f, 1.f, 1.f}, cs1 = cs0, sn0 = {0.f, 0.f, 0.f, 0.f}, sn1 = sn0;
                if (wc == 0) { const int ri = row * 16 + (fq & 1) * 8; cs0 = *(const f32x4*)(ropec + ri); cs1 = *(const f32x4*)(ropec + ri + 4); sn0 = *(const f32x4*)(ropes + ri); sn1 = *(const f32x4*)(ropes + ri + 4); }
#pragma unroll
                for (int bj = 0; bj < 2; ++bj) {
                    const LAS float* rp = red + (rl * 2 + bj) * 4;
                    const float inv = 1.0f / sqrtf(((rp[0] + rp[1]) + (rp[2] + rp[3])) * (1.0f / HD) + EPS);
                    const float f = s * inv;
                    f32x4 v0 = acc[ai][bj][m][0] * g0 * f, v1 = acc[ai][bj][m][1] * g1 * f;
                    if (wc == 0) {
                        f32x4 p0, p1;
#pragma unroll
                        for (int j = 0; j < 4; ++j) { p0[j] = __shfl_xor(v0[j], 32); p1[j] = __shfl_xor(v1[j], 32); }
                        const float sg = (fq < 2) ? -1.0f : 1.0f;
                        v0 = v0 * cs0 + p0 * sn0 * sg; v1 = v1 * cs1 + p1 * sn1 * sg;
                    }
                    v4u w; w.x = pk2(v0[0], v0[1]); w.y = pk2(v0[2], v0[3]); w.z = pk2(v1[0], v1[1]); w.w = pk2(v1[2], v1[3]);
                    *(v4u*)(proj + (size_t)row * INW + col0 + bj * 128) = w;
                }
            }
        __builtin_amdgcn_s_barrier();
    }
};
DI void narrow16(v4u w, v2u& ra, v2u& rb) {
    const auto sx = __builtin_amdgcn_permlane16_swap(w.x, w.z, false, false), sy = __builtin_amdgcn_permlane16_swap(w.y, w.w, false, false);
    ra = (v2u){sx[0], sy[0]}; rb = (v2u){sx[1], sy[1]};
}
DI v4u widen16(v2u a, v2u b) {
    const auto rx = __builtin_amdgcn_permlane16_swap(a.x, b.x, false, false), ry = __builtin_amdgcn_permlane16_swap(a.y, b.y, false, false);
    return (v4u){rx[0], ry[0], rx[1], ry[1]};
}
struct EpiG4 {
    static constexpr bool PERM = true; static constexpr int MIDK = 0;
    unsigned char* ws; const float* bgate;
    DI void operator()(const pg8::f32x4 (&acc)[2][2][4][2], const pg8::Unit& u, int wr, int wc, int fr, int fq) const {
        asm volatile("" : "+v"(fr), "+v"(fq));
        unsigned char* gates = ws + WS_GATES; const float* rowf = (const float*)(ws + WS_ROWF4); const float cs = *(const float*)(ws + WS_SW1 + (size_t)INW * 4);
        const int row0 = u.pm * 256 + wr * 64 + fr, col0 = u.pn * 256 + wc * 32 + 8 * fq;
        const int colw = u.pn * 256 + wc * 32 + 8 * (fq & ~1), rsel = fq & 1;
        f32x4 bq[2][2];
#pragma unroll
        for (int bj = 0; bj < 2; ++bj)
#pragma unroll
            for (int n = 0; n < 2; ++n) bq[bj][n] = *(const f32x4*)(bgate + col0 + bj * 128 + 4 * n) * (-1.4426950408889634f) - 8.0f;
#pragma unroll
        for (int ai = 0; ai < 2; ++ai)
#pragma unroll
            for (int mp = 0; mp < 2; ++mp) {
                v2u w[2][2];
#pragma unroll
                for (int mm = 0; mm < 2; ++mm) { const int m = 2 * mp + mm;
                    const int row = row0 + ai * 128 + m * 16; const float s = rowf[row] * cs * (-1.4426950408889634f);
#pragma unroll
                    for (int bj = 0; bj < 2; ++bj) {
                        f32x4 v0 = acc[ai][bj][m][0] * s + bq[bj][0], v1 = acc[ai][bj][m][1] * s + bq[bj][1];
#pragma unroll
                        for (int j = 0; j < 4; ++j) { v0[j] = __builtin_amdgcn_rcpf(0.00390625f + __builtin_amdgcn_exp2f(v0[j])); v1[j] = __builtin_amdgcn_rcpf(0.00390625f + __builtin_amdgcn_exp2f(v1[j])); }
                        w[mm][bj].x = pk4_fp8(v0[0], v0[1], v0[2], v0[3]); w[mm][bj].y = pk4_fp8(v1[0], v1[1], v1[2], v1[3]);
                    }
                }
                const int rowst = row0 + ai * 128 + (2 * mp + rsel) * 16;
#pragma unroll
                for (int bj = 0; bj < 2; ++bj) *(v4u*)(gates + (size_t)rowst * GATEW + colw + bj * 128) = widen16(w[0][bj], w[1][bj]);
            }
    }
};
struct EpiMerge {
    static constexpr bool PERM = true; static constexpr int MIDK = 4;
    const unsigned char* gates; unsigned char* out; const float* swa; const float* swb;
    DI void mid(pg8::f32x4 (&acc)[2][2][4][2], const pg8::Unit& u, int wr, int wc, int fr, int fq) const {
        asm volatile("" : "+v"(fr), "+v"(fq));
        const int row0 = u.pm * 256 + wr * 64 + fr, col0 = u.pn * 256 + wc * 32 + 8 * fq;
#pragma unroll
        for (int bj = 0; bj < 2; ++bj) {
            const int col = col0 + bj * 128;
            const float rr = swb[0] * __builtin_amdgcn_rcpf(swa[0]);
#pragma unroll
            for (int ai = 0; ai < 2; ++ai) {
#pragma unroll
                for (int mp = 0; mp < 2; ++mp) {
                    const size_t go = (size_t)(row0 + ai * 128 + (2 * mp + (fq & 1)) * 16) * GATEW + col - 8 * (fq & 1);
                    const v4u wa = *(const v4u*)(gates + go), wb = *(const v4u*)(gates + go + DM);
                    v2u ga[2], gb[2]; narrow16(wa, ga[0], ga[1]); narrow16(wb, gb[0], gb[1]);
#pragma unroll
                    for (int mm = 0; mm < 2; ++mm) { const int m = 2 * mp + mm;
                        float fa[8], fb[8]; unp8_fp8(ga[mm], fa); unp8_fp8(gb[mm], fb);
#pragma unroll
                        for (int j = 0; j < 4; ++j) {
                            acc[ai][bj][m][0][j] *= rr * fb[j] * __builtin_amdgcn_rcpf(fmaxf(fa[j], 1e-30f));
                            acc[ai][bj][m][1][j] *= rr * fb[4 + j] * __builtin_amdgcn_rcpf(fmaxf(fa[4 + j], 1e-30f));
                        }
                    }
                    asm volatile("" ::: "memory");
                }
            }
        }
    }
    DI void operator()(const pg8::f32x4 (&acc)[2][2][4][2], const pg8::Unit& u, int wr, int wc, int fr, int fq) const {
        const int row0 = u.pm * 256 + wr * 64 + fr, col0 = u.pn * 256 + wc * 32 + 8 * fq;
        v2u gq[2][2][4];
        {
            v4u gw_[2][2][2];
#pragma unroll
            for (int bj = 0; bj < 2; ++bj)
#pragma unroll
                for (int ai = 0; ai < 2; ++ai)
#pragma unroll
                    for (int mp = 0; mp < 2; ++mp) gw_[bj][ai][mp] = *(const v4u*)(gates + (size_t)(row0 + ai * 128 + (2 * mp + (fq & 1)) * 16) * GATEW + col0 + bj * 128 - 8 * (fq & 1));
#pragma unroll
            for (int bj = 0; bj < 2; ++bj)
#pragma unroll
                for (int ai = 0; ai < 2; ++ai)
#pragma unroll
                    for (int mp = 0; mp < 2; ++mp) narrow16(gw_[bj][ai][mp], gq[bj][ai][2 * mp], gq[bj][ai][2 * mp + 1]);
        }
#pragma unroll
        for (int bj = 0; bj < 2; ++bj) {
            const int col = col0 + bj * 128;
            const float c0 = swa[0] * (MSCALE / (YSCALE * 256.0f)), c1 = c0;
#pragma unroll
            for (int ai = 0; ai < 2; ++ai)
#pragma unroll
                for (int mp = 0; mp < 2; ++mp) {
                    v2u w[2];
#pragma unroll
                    for (int mm = 0; mm < 2; ++mm) { const int m = 2 * mp + mm;
                        const v2u g = gq[bj][ai][m];
                        float fg[8]; unp8_fp8(g, fg);
                        f32x4 v0 = acc[ai][bj][m][0] * c0, v1 = acc[ai][bj][m][1] * c1;
#pragma unroll
                        for (int j = 0; j < 4; ++j) { v0[j] *= fmaxf(fg[j], 1e-30f); v1[j] *= fmaxf(fg[4 + j], 1e-30f); }
                        w[mm].x = pk4_fp8(v0[0], v0[1], v0[2], v0[3]); w[mm].y = pk4_fp8(v1[0], v1[1], v1[2], v1[3]);
                    }
                    *(v4u*)(out + (size_t)(row0 + ai * 128 + (2 * mp + (fq & 1)) * 16) * DM + col - 8 * (fq & 1)) = widen16(w[0], w[1]);
                }
        }
    }
};
struct EpiOut {
    static constexpr bool PERM = true; static constexpr int MIDK = 0;
    const float* x; float* out; const float* sw; bf16* x1b; float* rowpart;
    DI void operator()(const pg8::f32x4 (&acc)[2][2][4][2], const pg8::Unit& u, int wr, int wc, int fr, int fq) const {
        const int row0 = u.pm * 256 + wr * 64 + fr, col0 = u.pn * 256 + wc * 32 + 8 * fq;
        const float cs1 = sw[0] * (1.0f / MSCALE);
#pragma unroll
        for (int ai = 0; ai < 2; ++ai)
#pragma unroll
            for (int m = 0; m < 4; ++m) {
                const int row = row0 + ai * 128 + m * 16; const size_t ro = (size_t)row * DM + col0;
                float ss = 0.f;
#pragma unroll
                for (int bj = 0; bj < 2; ++bj) {
                    const f32x4 x0 = *(const f32x4*)(x + ro + bj * 128), x1 = *(const f32x4*)(x + ro + bj * 128 + 4);
                    const f32x4 v0 = x0 + acc[ai][bj][m][0] * cs1, v1 = x1 + acc[ai][bj][m][1] * cs1;
                    v4u w; w.x = pk2(v0.x, v0.y); w.y = pk2(v0.z, v0.w); w.z = pk2(v1.x, v1.y); w.w = pk2(v1.z, v1.w); *(v4u*)(x1b + ro + bj * 128) = w;
                    ss += ((v0.x * v0.x + v0.y * v0.y) + (v0.z * v0.z + v0.w * v0.w)) + ((v1.x * v1.x + v1.y * v1.y) + (v1.z * v1.z + v1.w * v1.w));
                }
                ss += __shfl_xor(ss, 16); ss += __shfl_xor(ss, 32);
                if (fq == 0) rowpart[(size_t)row * 64 + u.pn * 4 + wc] = ss;
            }
    }
};
struct EpiQ {
    static constexpr bool PERM = true; static constexpr int MIDK = 0;
    bf16* q; const LAS float* inv2l;
    DI void operator()(const pg8::f32x4 (&acc)[2][2][4][2], const pg8::Unit& u, int wr, int wc, int fr, int fq) const {
        const int rl0 = wr * 64 + fr, col0 = u.pn * 256 + wc * 32 + 8 * fq;
#pragma unroll
        for (int ai = 0; ai < 2; ++ai)
#pragma unroll
            for (int m = 0; m < 4; ++m) {
                const int rl = rl0 + ai * 128 + m * 16; const float s = inv2l[rl]; const int row = u.pm * 256 + rl;
#pragma unroll
                for (int bj = 0; bj < 2; ++bj) {
                    const f32x4 v0 = acc[ai][bj][m][0] * s, v1 = acc[ai][bj][m][1] * s;
                    v4u w; w.x = pk2(v0[0], v0[1]); w.y = pk2(v0[2], v0[3]); w.z = pk2(v1[0], v1[1]); w.w = pk2(v1[2], v1[3]);
                    *(v4u*)(q + (size_t)row * QW + col0 + bj * 128) = w;
                }
            }
    }
};

template <int MODE> DI void transpose_tile(const float* W, int N, unsigned char* dst, int ldt, int row_off, int col_off, const float* gain, float qs, LAS float* scr, int item, int lane) {
    const int nblk = N / 32, kb = item / nblk, nb = item % nblk, k0 = 128 * kb, n0 = 32 * nb;
    const int kr = lane >> 3, nc = (lane & 7) * 4;
    f32x4 v[16]; float g[16];
#pragma unroll
    for (int i = 0; i < 16; ++i) { v[i] = __builtin_nontemporal_load((const f32x4*)(W + (size_t)(k0 + 8 * i + kr) * N + n0 + nc)); g[i] = (gain ? gain[k0 + 8 * i + kr] : 1.0f) * qs; }
#pragma unroll
    for (int i = 0; i < 16; ++i) { LAS float* d = scr + (8 * i + kr) * 33 + nc; d[0] = v[i].x * g[i]; d[1] = v[i].y * g[i]; d[2] = v[i].z * g[i]; d[3] = v[i].w * g[i]; }
    asm volatile("s_waitcnt lgkmcnt(0)" ::: "memory");
    const int c = lane & 15;
#pragma unroll
    for (int j = 0; j < 8; ++j) { const int n = (lane >> 4) + 4 * j; const LAS float* s = scr + (8 * c) * 33 + n;
        unsigned char* orow = dst + (size_t)(row_off + n0 + n) * ldt + col_off;
        if constexpr (MODE == 0) { v4u o; o.x = pk2(s[0 * 33], s[1 * 33]); o.y = pk2(s[2 * 33], s[3 * 33]); o.z = pk2(s[4 * 33], s[5 * 33]); o.w = pk2(s[6 * 33], s[7 * 33]); *(v4u*)(orow + (k0 + 8 * c) * 2) = o; }
        else if constexpr (MODE == 1) { v2u o; o.x = pk4_fp8(s[0 * 33], s[1 * 33], s[2 * 33], s[3 * 33]); o.y = pk4_fp8(s[4 * 33], s[5 * 33], s[6 * 33], s[7 * 33]); *(v2u*)(orow + k0 + 8 * c) = o; }
        else {
#define SAT6(x) fminf(fmaxf((x), -6.0f), 6.0f)
            unsigned p = 0;
            p = __builtin_amdgcn_cvt_scalef32_pk_fp4_f32(p, SAT6(s[0 * 33]), SAT6(s[1 * 33]), 1.0f, 0); p = __builtin_amdgcn_cvt_scalef32_pk_fp4_f32(p, SAT6(s[2 * 33]), SAT6(s[3 * 33]), 1.0f, 1);
            p = __builtin_amdgcn_cvt_scalef32_pk_fp4_f32(p, SAT6(s[4 * 33]), SAT6(s[5 * 33]), 1.0f, 2); p = __builtin_amdgcn_cvt_scalef32_pk_fp4_f32(p, SAT6(s[6 * 33]), SAT6(s[7 * 33]), 1.0f, 3);
#undef SAT6
            *(unsigned*)(orow + (k0 + 8 * c) / 2) = p; }
    }
    asm volatile("s_waitcnt lgkmcnt(0)" ::: "memory");
}
DI void transpose_item_fp8(const float* W, int K, int N, unsigned char* WT8, int ldt, int row_off, int col_off, const float* gain, float qs, LAS float* scr, int item, int lane) {
    const int nblk = N / 64, kb = item / nblk, nb = item % nblk, k0 = 64 * kb, n0 = 64 * nb;
    const int kr = lane >> 4, nc = (lane & 15) * 4;
    f32x4 v[16]; float g[16];
#pragma unroll
    for (int i = 0; i < 16; ++i) { v[i] = __builtin_nontemporal_load((const f32x4*)(W + (size_t)(k0 + 4 * i + kr) * N + n0 + nc)); g[i] = (gain ? gain[k0 + 4 * i + kr] : 1.0f) * qs; }
#pragma unroll
    for (int i = 0; i < 16; ++i) { LAS float* d = scr + (4 * i + kr) * 65 + nc; d[0] = v[i].x * g[i]; d[1] = v[i].y * g[i]; d[2] = v[i].z * g[i]; d[3] = v[i].w * g[i]; }
    asm volatile("s_waitcnt lgkmcnt(0)" ::: "memory");
    const int c = lane & 7;
#pragma unroll
    for (int j = 0; j < 8; ++j) { const int n = (lane >> 3) + 8 * j; const LAS float* s = scr + (8 * c) * 65 + n;
        v2u o; o.x = pk4_fp8(s[0 * 65], s[1 * 65], s[2 * 65], s[3 * 65]); o.y = pk4_fp8(s[4 * 65], s[5 * 65], s[6 * 65], s[7 * 65]);
        *(v2u*)(WT8 + (size_t)(row_off + n0 + n) * ldt + col_off + k0 + 8 * c) = o; }
    asm volatile("s_waitcnt lgkmcnt(0)" ::: "memory");
}
DI void transpose_item_fp4(const float* W, int K, int N, unsigned char* WT4, int ldt, const float* gain, float qs, LAS float* scr, int item, int lane) {
    const int nblk = N / 64, kb = item / nblk, nb = item % nblk, k0 = 64 * kb, n0 = 64 * nb;
    const int kr = lane >> 4, nc = (lane & 15) * 4;
    f32x4 v[16]; float g[16];
#pragma unroll
    for (int i = 0; i < 16; ++i) { v[i] = __builtin_nontemporal_load((const f32x4*)(W + (size_t)(k0 + 4 * i + kr) * N + n0 + nc)); g[i] = (gain ? gain[k0 + 4 * i + kr] : 1.0f) * qs; }
#pragma unroll
    for (int i = 0; i < 16; ++i) { LAS float* d = scr + (4 * i + kr) * 65 + nc; d[0] = v[i].x * g[i]; d[1] = v[i].y * g[i]; d[2] = v[i].z * g[i]; d[3] = v[i].w * g[i]; }
    asm volatile("s_waitcnt lgkmcnt(0)" ::: "memory");
    const int c = lane & 7;
#pragma unroll
    for (int j = 0; j < 8; ++j) { const int n = (lane >> 3) + 8 * j; const LAS float* s = scr + (8 * c) * 65 + n;
#define SAT6(x) fminf(fmaxf((x), -6.0f), 6.0f)
        unsigned p = 0;
        p = __builtin_amdgcn_cvt_scalef32_pk_fp4_f32(p, SAT6(s[0 * 65]), SAT6(s[1 * 65]), 1.0f, 0); p = __builtin_amdgcn_cvt_scalef32_pk_fp4_f32(p, SAT6(s[2 * 65]), SAT6(s[3 * 65]), 1.0f, 1);
        p = __builtin_amdgcn_cvt_scalef32_pk_fp4_f32(p, SAT6(s[4 * 65]), SAT6(s[5 * 65]), 1.0f, 2); p = __builtin_amdgcn_cvt_scalef32_pk_fp4_f32(p, SAT6(s[6 * 65]), SAT6(s[7 * 65]), 1.0f, 3);
#undef SAT6
        *(unsigned*)(WT4 + (size_t)(n0 + n) * ldt + (k0 + 8 * c) / 2) = p; }
    asm volatile("s_waitcnt lgkmcnt(0)" ::: "memory");
}
DI void wg_sample_all(const float* w_in, const float* w_gate, const float* w_a, const float* w_b, const float* w_o, const float* gain, LAS float* red,
                      float& m_in, float& m_g, float& rms_g, float& m_a, float& m_b, float& m_o) {
    const int k = threadIdx.x >> 7, c = threadIdx.x & 127;
    f32x4 vi[8], va[4], vb[4], vo[4], vg[8];
#pragma unroll
    for (int i = 0; i < 8; ++i) vi[i] = *(const f32x4*)(w_in + (size_t)k * INW + 4 * (c + 256 * i));
#pragma unroll
    for (int i = 0; i < 4; ++i) { va[i] = *(const f32x4*)(w_a + (size_t)k * DM + 4 * (c + 256 * i)); vb[i] = *(const f32x4*)(w_b + (size_t)k * DM + 4 * (c + 256 * i)); vo[i] = *(const f32x4*)(w_o + (size_t)k * DM + 4 * (c + 256 * i)); }
#pragma unroll
    for (int i = 0; i < 8; ++i) vg[i] = *(const f32x4*)(w_gate + (size_t)k * GATEW + 4 * (c + 256 * i));
    const float g = gain[k];
    float xi = 0.f, xa = 0.f, xb = 0.f, xo = 0.f, xg = 0.f, sg = 0.f;
#pragma unroll
    for (int i = 0; i < 8; ++i) xi = fmaxf(xi, fmaxf(fmaxf(fabsf(vi[i].x), fabsf(vi[i].y)), fmaxf(fabsf(vi[i].z), fabsf(vi[i].w))));
    xi *= fabsf(g);
#pragma unroll
    for (int i = 0; i < 4; ++i) {
        xa = fmaxf(xa, fmaxf(fmaxf(fabsf(va[i].x), fabsf(va[i].y)), fmaxf(fabsf(va[i].z), fabsf(va[i].w))));
        xb = fmaxf(xb, fmaxf(fmaxf(fabsf(vb[i].x), fabsf(vb[i].y)), fmaxf(fabsf(vb[i].z), fabsf(vb[i].w))));
        xo = fmaxf(xo, fmaxf(fmaxf(fabsf(vo[i].x), fabsf(vo[i].y)), fmaxf(fabsf(vo[i].z), fabsf(vo[i].w))));
    }
#pragma unroll
    for (int i = 0; i < 8; ++i) { const float a0 = vg[i].x * g, a1 = vg[i].y * g, a2 = vg[i].z * g, a3 = vg[i].w * g; xg = fmaxf(xg, fmaxf(fmaxf(fabsf(a0), fabsf(a1)), fmaxf(fabsf(a2), fabsf(a3)))); sg += a0 * a0 + a1 * a1 + a2 * a2 + a3 * a3; }
#pragma unroll
    for (int o = 1; o < 64; o <<= 1) { xi = fmaxf(xi, __shfl_xor(xi, o)); xa = fmaxf(xa, __shfl_xor(xa, o)); xb = fmaxf(xb, __shfl_xor(xb, o)); xo = fmaxf(xo, __shfl_xor(xo, o)); xg = fmaxf(xg, __shfl_xor(xg, o)); sg += __shfl_xor(sg, o); }
    __syncthreads();
    if ((threadIdx.x & 63) == 0) { LAS float* r = red + 8 * (threadIdx.x >> 6); r[0] = xi; r[1] = xa; r[2] = xb; r[3] = xo; r[4] = xg; r[5] = sg; }
    __syncthreads();
    xi = red[0]; xa = red[1]; xb = red[2]; xo = red[3]; xg = red[4]; sg = red[5];
#pragma unroll
    for (int w = 1; w < NWAVES; ++w) { xi = fmaxf(xi, red[8 * w]); xa = fmaxf(xa, red[8 * w + 1]); xb = fmaxf(xb, red[8 * w + 2]); xo = fmaxf(xo, red[8 * w + 3]); xg = fmaxf(xg, red[8 * w + 4]); sg += red[8 * w + 5]; }
    m_in = xi; m_a = xa; m_b = xb; m_o = xo; m_g = xg; rms_g = sqrtf(sg / 16384.0f);
}
DI float wg_sample_stats(const float* W, int N, const float* gain, LAS float* red, float* rms_out) {
    float mx = 0.f, ss = 0.f;
    for (int idx = threadIdx.x; idx < N; idx += NTHREADS) {
#pragma unroll
        for (int k = 0; k < 4; ++k) { const float v = W[(size_t)k * N + idx] * (gain ? gain[k] : 1.0f); mx = fmaxf(mx, fabsf(v)); ss += v * v; }
    }
#pragma unroll
    for (int o = 1; o < 64; o <<= 1) { mx = fmaxf(mx, __shfl_xor(mx, o)); ss += __shfl_xor(ss, o); }
    __syncthreads();
    if ((threadIdx.x & 63) == 0) { red[threadIdx.x >> 6] = mx; red[8 + (threadIdx.x >> 6)] = ss; }
    __syncthreads();
    float r = red[0], s = red[8];
#pragma unroll
    for (int w = 1; w < NWAVES; ++w) { r = fmaxf(r, red[w]); s += red[8 + w]; }
    *rms_out = sqrtf(s / (4.0f * N));
    return r;
}
DI float wg_sample_absmax(const float* W, int N, const float* gain, LAS float* red) {
    float mx = 0.f;
    for (int idx = threadIdx.x; idx < N; idx += NTHREADS) {
#pragma unroll
        for (int k = 0; k < 4; ++k) mx = fmaxf(mx, fabsf(W[(size_t)k * N + idx] * (gain ? gain[k] : 1.0f)));
    }
#pragma unroll
    for (int o = 1; o < 64; o <<= 1) mx = fmaxf(mx, __shfl_xor(mx, o));
    __syncthreads();
    if ((threadIdx.x & 63) == 0) red[threadIdx.x >> 6] = mx;
    __syncthreads();
    float r = red[0];
#pragma unroll
    for (int w = 1; w < NWAVES; ++w) r = fmaxf(r, red[w]);
    return r;
}
DI void transpose_item(const float* W, int K, int N, bf16* WT, int ldt, int row_off, const float* gain, LAS float* scr, int item, int lane) {
    const int nblk = N / 64, kb = item / nblk, nb = item % nblk, k0 = 64 * kb, n0 = 64 * nb;
    const int kr = lane >> 4, nc = (lane & 15) * 4;
    f32x4 v[16]; float g[16];
#pragma unroll
    for (int i = 0; i < 16; ++i) { v[i] = __builtin_nontemporal_load((const f32x4*)(W + (size_t)(k0 + 4 * i + kr) * N + n0 + nc)); g[i] = gain ? gain[k0 + 4 * i + kr] : 1.0f; }
#pragma unroll
    for (int i = 0; i < 16; ++i) { LAS float* d = scr + (4 * i + kr) * 65 + nc; d[0] = v[i].x * g[i]; d[1] = v[i].y * g[i]; d[2] = v[i].z * g[i]; d[3] = v[i].w * g[i]; }
    asm volatile("s_waitcnt lgkmcnt(0)" ::: "memory");
    const int c = lane & 7;
#pragma unroll
    for (int j = 0; j < 8; ++j) { const int n = (lane >> 3) + 8 * j; const LAS float* s = scr + (8 * c) * 65 + n;
        v4u o; o.x = pk2(s[0 * 65], s[1 * 65]); o.y = pk2(s[2 * 65], s[3 * 65]); o.z = pk2(s[4 * 65], s[5 * 65]); o.w = pk2(s[6 * 65], s[7 * 65]);
        *(v4u*)(WT + (size_t)(row_off + n0 + n) * ldt + k0 + 8 * c) = o; }
    asm volatile("s_waitcnt lgkmcnt(0)" ::: "memory");
}

constexpr int ATT_PITCH = 272;
constexpr int ATT_SLOT = 256 * ATT_PITCH;
constexpr int ATT_ITEMS = 1024 + 768;
DI int crow(int reg, int h) { return (reg & 3) + 8 * (reg >> 2) + 4 * h; }

struct AttItem { int qcol, kcol, vcol, dil, res, n, maxd, old, hh, g; float sink; bf16* obase; bool has_lse; };
DI AttItem att_decode(int it, const float* sinks, unsigned char* ycat, bf16* outg) {
    AttItem a; a.hh = 0; a.g = 0;
    if (it < 1024) {
        const int qh = it >> 6; a.n = it & 63; a.qcol = COL_QA + qh * 128; a.kcol = COL_KA + (qh >> 2) * 128; a.vcol = COL_VA + (qh >> 2) * 128;
        a.dil = 1; a.res = 0; a.maxd = 127; a.sink = sinks[qh]; a.obase = (bf16*)(ycat + 512 + qh * 128); a.old = YCW; a.has_lse = false;
    } else {
        const int j = it - 1024; a.g = j >> 8; const int rem = j & 255; a.hh = rem >> 6; const int blk = rem & 63;
        a.dil = (a.g == 0) ? 1 : (a.g == 1 ? 4 : 16); a.res = blk % a.dil; a.n = blk / a.dil;
        const int hb = 4 * a.g + a.hh; a.qcol = COL_QB + hb * 128; a.kcol = COL_KB + hb * 128; a.vcol = COL_VB + hb * 128;
        a.maxd = 128; a.sink = -__builtin_inff(); a.obase = outg + (size_t)a.g * SEQ * 512 + a.hh * 128; a.old = 512; a.has_lse = true;
    }
    return a;
}
DI void att_fetch(v4u (&w)[16], const bf16* proj, int col, int dil, int res, int n, int st) {
    const int ch = st & 15, r0 = st >> 4;
    const size_t rstep = (size_t)16 * dil * INW;
#pragma unroll
    for (int hb = 0; hb < 2; ++hb) {
        if (n > 0 || hb == 1) {
            const bf16* gp = proj + (size_t)(res + dil * (128 * (n - 1) + 128 * hb + r0)) * INW + col + ch * 8;
#pragma unroll
            for (int ps = 0; ps < 8; ++ps) w[hb * 8 + ps] = *(const v4u*)(gp + ps * rstep);
        } else {
#pragma unroll
            for (int ps = 0; ps < 8; ++ps) w[hb * 8 + ps] = (v4u){0u, 0u, 0u, 0u};
        }
    }
}
DI void att_store(LAS unsigned char* slot, const v4u (&w)[16], int st) {
    LAS unsigned char* lp = slot + (st >> 4) * ATT_PITCH + (st & 15) * 16;
#pragma unroll
    for (int ps = 0; ps < 16; ++ps) *(LAS v4u*)(lp + ps * 16 * ATT_PITCH) = w[ps];
}

DI void attention_phase(LAS unsigned char* lds, const bf16* proj, const float* sinks, unsigned char* ycat, bf16* outg, float* lse, int bid, int G) {
    const int tid = threadIdx.x, lane = tid & 63, wave = __builtin_amdgcn_readfirstlane(tid >> 6);
    const int slot_id = wave >> 2, w = wave & 3, st = tid & 255;
    const int r = lane & 31, h = lane >> 5;
    LAS unsigned char* slot = lds + slot_id * ATT_SLOT;
    const float c_scale = 0.08838834764831845f, LOG2E = 1.4426950408889634f;
    v4u kw[16];
    if (bid < ATT_ITEMS / 2) { const AttItem a0 = att_decode(2 * bid + slot_id, sinks, ycat, outg); att_fetch(kw, proj, a0.kcol, a0.dil, a0.res, a0.n, st); }
#pragma unroll 1
    for (int pair = bid; pair < ATT_ITEMS / 2; pair += G) {
        const AttItem a = att_decode(2 * pair + slot_id, sinks, ycat, outg);
        const int n = a.n;
        att_store(slot, kw, st);
        const int iq = 128 * n + 32 * w + r, qpos = a.res + a.dil * iq;
        bf16x8 qf[8];
#pragma unroll
        for (int ks = 0; ks < 8; ++ks) qf[ks] = *(const bf16x8*)(proj + (size_t)qpos * INW + a.qcol + 16 * ks + 8 * h);
        __syncthreads();
        f32x16 sacc[5];
#pragma unroll
        for (int kbi = 0; kbi < 5; ++kbi) {
#pragma unroll
            for (int i = 0; i < 16; ++i) sacc[kbi][i] = 0.f;
#pragma unroll
            for (int ks = 0; ks < 8; ++ks) {
                const bf16x8 af = *(const LAS bf16x8*)(slot + (32 * (w + kbi) + r) * ATT_PITCH + (16 * ks + 8 * h) * 2);
                sacc[kbi] = __builtin_amdgcn_mfma_f32_32x32x16_bf16(af, qf[ks], sacc[kbi], 0, 0, 0);
            }
            asm volatile("" ::: "memory");
        }
        v4u vw[16];
        att_fetch(vw, proj, a.vcol, a.dil, a.res, n, st);
        int base = r - 4 * h; asm volatile("" : "+v"(base));
        const int lim = (n > 0) ? a.maxd : min(a.maxd, 32 * w + r);
        float mx = -__builtin_inff();
#pragma unroll
        for (int kbi = 0; kbi < 5; ++kbi)
#pragma unroll
            for (int i = 0; i < 16; ++i) {
                const int dist = base + (128 - 32 * kbi - (i & 3) - 8 * (i >> 2));
                const bool valid = (unsigned)dist <= (unsigned)lim;
                const float s = valid ? sacc[kbi][i] : -__builtin_inff();
                sacc[kbi][i] = s; mx = fmaxf(mx, s);
            }
        mx = fmaxf(mx, __shfl_xor(mx, 32));
        const float m_sc = fmaxf(mx * c_scale, a.sink);
        const float mb = m_sc * LOG2E, c2 = c_scale * LOG2E;
        float l = 0.f;
#pragma unroll
        for (int kbi = 0; kbi < 5; ++kbi)
#pragma unroll
            for (int i = 0; i < 16; ++i) { const float p = __builtin_amdgcn_exp2f(sacc[kbi][i] * c2 - mb); sacc[kbi][i] = p; l += p; }
        l += __shfl_xor(l, 32);
        l += __builtin_amdgcn_exp2f(a.sink * LOG2E - mb);
        const float rl = 1.0f / l;
        if (a.has_lse && h == 0) lse[((size_t)a.g * SEQ + qpos) * 4 + a.hh] = m_sc + __logf(l);
        bf16x8 pf[5][2];
#pragma unroll
        for (int kbi = 0; kbi < 5; ++kbi)
#pragma unroll
            for (int s = 0; s < 2; ++s) {
                v4u pw; pw.x = pk2(sacc[kbi][8 * s + 0], sacc[kbi][8 * s + 1]); pw.y = pk2(sacc[kbi][8 * s + 2], sacc[kbi][8 * s + 3]);
                pw.z = pk2(sacc[kbi][8 * s + 4], sacc[kbi][8 * s + 5]); pw.w = pk2(sacc[kbi][8 * s + 6], sacc[kbi][8 * s + 7]);
                pf[kbi][s] = __builtin_bit_cast(bf16x8, pw);
            }
        __syncthreads();
        att_store(slot, vw, st);
        __syncthreads();
        { const int pnx = (pair + G < ATT_ITEMS / 2) ? pair + G : pair;
          const AttItem an = att_decode(2 * pnx + slot_id, sinks, ycat, outg); att_fetch(kw, proj, an.kcol, an.dil, an.res, an.n, st); }
        f32x16 oacc[4];
#pragma unroll
        for (int db = 0; db < 4; ++db)
#pragma unroll
            for (int i = 0; i < 16; ++i) oacc[db][i] = 0.f;
        const int q4 = (lane & 15) >> 2, p4 = lane & 3, blk16 = (lane >> 4) & 1;
#pragma unroll
        for (int kbi = 0; kbi < 5; ++kbi)
#pragma unroll
            for (int s = 0; s < 2; ++s) {
                const int key0 = 32 * (w + kbi) + 16 * s + 4 * h + q4;
#pragma unroll
                for (int db = 0; db < 4; ++db) {
                    const LAS unsigned char* a0 = slot + key0 * ATT_PITCH + (32 * db + 16 * blk16) * 2 + 8 * p4;
                    const s16x4 lo = __builtin_amdgcn_ds_read_tr16_b64_v4i16((LAS s16x4*)a0);
                    const s16x4 hi = __builtin_amdgcn_ds_read_tr16_b64_v4i16((LAS s16x4*)(a0 + 8 * ATT_PITCH));
                    const bf16x8 va = __builtin_shufflevector(lo, hi, 0, 1, 2, 3, 4, 5, 6, 7);
                    oacc[db] = __builtin_amdgcn_mfma_f32_32x32x16_bf16(va, pf[kbi][s], oacc[db], 0, 0, 0);
                }
                asm volatile("" ::: "memory");
            }
        if (a.has_lse) {
            bf16* orow = a.obase + (size_t)qpos * a.old;
#pragma unroll
            for (int db = 0; db < 4; ++db) {
                v2u o[4];
#pragma unroll
                for (int g4 = 0; g4 < 4; ++g4) { o[g4].x = pk2(oacc[db][4 * g4 + 0] * rl, oacc[db][4 * g4 + 1] * rl); o[g4].y = pk2(oacc[db][4 * g4 + 2] * rl, oacc[db][4 * g4 + 3] * rl); }
                const auto s02x = __builtin_amdgcn_permlane32_swap(o[0].x, o[2].x, false, false), s02y = __builtin_amdgcn_permlane32_swap(o[0].y, o[2].y, false, false);
                const auto s13x = __builtin_amdgcn_permlane32_swap(o[1].x, o[3].x, false, false), s13y = __builtin_amdgcn_permlane32_swap(o[1].y, o[3].y, false, false);
                *(v4u*)(orow + 32 * db + 16 * h) = (v4u){s02x[0], s02y[0], s02x[1], s02y[1]};
                *(v4u*)(orow + 32 * db + 16 * h + 8) = (v4u){s13x[0], s13y[0], s13x[1], s13y[1]};
            }
        } else {
            unsigned char* orow = (unsigned char*)a.obase + (size_t)qpos * a.old; const float rs = rl * YSCALE;
#pragma unroll
            for (int db = 0; db < 4; ++db) {
                unsigned d[4];
#pragma unroll
                for (int g4 = 0; g4 < 4; ++g4) d[g4] = pk4_fp8(oacc[db][4 * g4 + 0] * rs, oacc[db][4 * g4 + 1] * rs, oacc[db][4 * g4 + 2] * rs, oacc[db][4 * g4 + 3] * rs);
                const auto s02 = __builtin_amdgcn_permlane32_swap(d[0], d[2], false, false), s13 = __builtin_amdgcn_permlane32_swap(d[1], d[3], false, false);
                *(v4u*)(orow + 32 * db + 16 * h) = (v4u){s02[0], s02[1], s13[0], s13[1]};
            }
        }
        __syncthreads();
    }
}

DI void combine_phase(const bf16* outg, const float* lse, unsigned char* ycat, int gtid, int gthreads) {
    for (int idx = gtid; idx < SEQ * 64; idx += gthreads) {
        const int t = idx >> 6, ch = idx & 63, hh = ch >> 4, dd = (ch & 15) * 8;
        const float l0 = lse[((size_t)0 * SEQ + t) * 4 + hh], l1 = lse[((size_t)1 * SEQ + t) * 4 + hh], l2 = lse[((size_t)2 * SEQ + t) * 4 + hh];
        const float m = fmaxf(l0, fmaxf(l1, l2));
        float w0 = __expf(l0 - m), w1 = __expf(l1 - m), w2 = __expf(l2 - m); const float rs = 1.0f / (w0 + w1 + w2); w0 *= rs; w1 *= rs; w2 *= rs;
        const v4u a = *(const v4u*)(outg + ((size_t)0 * SEQ + t) * 512 + hh * 128 + dd);
        const v4u b = *(const v4u*)(outg + ((size_t)1 * SEQ + t) * 512 + hh * 128 + dd);
        const v4u c = *(const v4u*)(outg + ((size_t)2 * SEQ + t) * 512 + hh * 128 + dd);
        w0 *= YSCALE; w1 *= YSCALE; w2 *= YSCALE;
        v2u o;
        o.x = pk4_fp8(w0 * bflo(a.x) + w1 * bflo(b.x) + w2 * bflo(c.x), w0 * bfhi(a.x) + w1 * bfhi(b.x) + w2 * bfhi(c.x), w0 * bflo(a.y) + w1 * bflo(b.y) + w2 * bflo(c.y), w0 * bfhi(a.y) + w1 * bfhi(b.y) + w2 * bfhi(c.y));
        o.y = pk4_fp8(w0 * bflo(a.z) + w1 * bflo(b.z) + w2 * bflo(c.z), w0 * bfhi(a.z) + w1 * bfhi(b.z) + w2 * bfhi(c.z), w0 * bflo(a.w) + w1 * bflo(b.w) + w2 * bflo(c.w), w0 * bfhi(a.w) + w1 * bfhi(b.w) + w2 * bfhi(c.w));
        *(v2u*)(ycat + (size_t)t * YCW + hh * 128 + dd) = o;
    }
}

constexpr int RT_PITCH = 129;
DI int f2key(float f) { const int b = __builtin_bit_cast(int, f); return b ^ ((b >> 31) & 0x7fffffff); }
DI float key2f(int k) { const int b = k ^ ((k >> 31) & 0x7fffffff); return __builtin_bit_cast(float, b); }
#define TOPK_INSERT(arr, xx) do { int _x = (xx); _Pragma("unroll") for (int _j = 0; _j < 16; ++_j) { const int _hi = max(arr[_j], _x); _x = min(arr[_j], _x); arr[_j] = _hi; } } while (0)

DI void routing_block(LAS unsigned char* lds, const bf16* q, const bf16* skb, int* experts, float* pgates, int tb) {
    int tid = threadIdx.x; asm volatile("" : "+v"(tid));
    const int lane = tid & 63, wave = __builtin_amdgcn_readfirstlane(tid >> 6);
    const int r = lane & 31, h = lane >> 5;
    LAS int* sc = (LAS int*)lds;
#pragma unroll 1
    for (int hp = 0; hp < 2; ++hp) {
        const int t0 = tb * 32, hc = 8 * hp + wave;
        f32x16 acc[4];
#pragma unroll
        for (int kb = 0; kb < 4; ++kb)
#pragma unroll
            for (int i = 0; i < 16; ++i) acc[kb][i] = 0.f;
#pragma unroll
        for (int ks = 0; ks < 8; ++ks) {
            const bf16x8 a = *(const bf16x8*)(q + (size_t)(t0 + r) * QW + hc * 128 + 16 * ks + 8 * h);
#pragma unroll
            for (int kb = 0; kb < 4; ++kb) {
                const bf16x8 b = *(const bf16x8*)(skb + ((size_t)hc * 128 + 32 * kb + r) * 128 + 16 * ks + 8 * h);
                acc[kb] = __builtin_amdgcn_mfma_f32_32x32x16_bf16(a, b, acc[kb], 0, 0, 0);
            }
        }
#pragma unroll
        for (int kb = 0; kb < 4; ++kb)
#pragma unroll
            for (int i = 0; i < 16; ++i) {
                const int key = 32 * kb + r;
                sc[(crow(i, h) * 8 + wave) * RT_PITCH + key] = (f2key(acc[kb][i]) & ~127) | key;
            }
        __syncthreads();
        {
            int a[16];
#pragma unroll
            for (int j = 0; j < 16; ++j) a[j] = (int)0x80000000;
            LAS int* row = sc + (tid >> 1) * RT_PITCH; const int hf = tid & 1;
#pragma unroll 8
            for (int k = 0; k < 64; ++k) { const int x = row[64 * hf + k]; TOPK_INSERT(a, x); }
            __syncthreads();
#pragma unroll
            for (int j = 0; j < 16; ++j) row[16 * hf + j] = a[j];
            __syncthreads();
            if (hf == 0) {
#pragma unroll
                for (int j = 0; j < 16; ++j) { const int x = row[16 + j]; TOPK_INSERT(a, x); }
#pragma unroll
                for (int j = 0; j < 16; ++j) row[j] = a[j];
            }
        }
        __syncthreads();
        if (tid < 128) {
            LAS int* ra = sc + (2 * tid) * RT_PITCH; LAS int* rb = ra + RT_PITCH;
            float va[16], vb[16];
#pragma unroll
            for (int j = 0; j < 16; ++j) { va[j] = key2f(ra[j] & ~127); vb[j] = key2f(rb[j] & ~127); }
            int c[16];
#pragma unroll
            for (int j = 0; j < 16; ++j) c[j] = (int)0x80000000;
#pragma unroll
            for (int i = 0; i < 16; ++i)
#pragma unroll
                for (int j = 0; j < 16; ++j)
                    if ((i + 1) * (j + 1) <= 16) { const int x = (f2key(va[i] + vb[j]) & ~255) | (i * 16 + j); TOPK_INSERT(c, x); }
            int ex[16];
#pragma unroll
            for (int k = 0; k < 16; ++k) { const int id = c[k] & 255; ex[k] = (ra[id >> 4] & 127) * 128 + (rb[id & 15] & 127); }
            float e[16]; const float m0 = key2f(c[0] & ~255); float s2 = 0.f;
#pragma unroll
            for (int k = 0; k < 16; ++k) { e[k] = __expf(key2f(c[k] & ~255) - m0); s2 += e[k]; }
            const float rs = 1.0f / s2;
            const int t = t0 + (tid >> 2), hd = 4 * hp + (tid & 3);
            int* ep = experts + (size_t)t * 128 + hd * 16; float* gp = pgates + (size_t)t * 128 + hd * 16;
#pragma unroll
            for (int k4 = 0; k4 < 4; ++k4) {
                *(int4*)(ep + 4 * k4) = make_int4(ex[4 * k4], ex[4 * k4 + 1], ex[4 * k4 + 2], ex[4 * k4 + 3]);
                *(f32x4*)(gp + 4 * k4) = (f32x4){e[4 * k4] * rs, e[4 * k4 + 1] * rs, e[4 * k4 + 2] * rs, e[4 * k4 + 3] * rs};
            }
        }
        __syncthreads();
    }
}

typedef float f32x32 __attribute__((ext_vector_type(32)));
typedef unsigned v6u __attribute__((ext_vector_type(6)));
typedef unsigned v16u __attribute__((ext_vector_type(16)));
typedef __bf16 bf16x32 __attribute__((ext_vector_type(32)));
constexpr int ROW4 = 2048, RSLOT = 2 * ROW4;
DI float readlane_f(float v, int l) { return __builtin_bit_cast(float, __builtin_amdgcn_readlane(__builtin_bit_cast(int, v), l)); }
DI float wave_sum_dpp(float v) {
#define DPPF(x, ctrl, rmask) __builtin_bit_cast(float, __builtin_amdgcn_update_dpp(0, __builtin_bit_cast(int, x), ctrl, rmask, 0xf, false))
    v += DPPF(v, 0xB1, 0xf); v += DPPF(v, 0x4E, 0xf); v += DPPF(v, 0x141, 0xf); v += DPPF(v, 0x140, 0xf);
    v += DPPF(v, 0x142, 0xa); v += DPPF(v, 0x143, 0xc);
#undef DPPF
    return readlane_f(v, 63);
}
DI float gelu_exact(float v) {
    const float av = fabsf(v), t = __builtin_amdgcn_rcpf(av * 0.2316418882f + 1.0f);
    float q = t * 0.5307027145f + (-0.7265760135f); q = q * t + 0.7107068705f; q = q * t + (-0.142248368f); q = q * t + 0.127414796f; q = q * t;
    const float e = __builtin_amdgcn_exp2f((v * v) * (-0.72134752044f));
    const float m = v * (q * e);
    return v < 0.f ? m : v - m;
}
#define P11_DMA(gsrc, ldst, NP) do { _Pragma("unroll") for (int _i = 0; _i < (NP); ++_i) \
    __builtin_amdgcn_global_load_lds((const unsigned*)((gsrc) + _i * 1024), (LAS unsigned*)((ldst) + _i * 1024), 16, 0, 0); } while (0)
DI void peer_token(LAS unsigned char* ring, const bf16* x1row, float inv2, const float* nffn, const int* ex, const float* pg, const unsigned char* U6, const unsigned char* V6,
                   const float* usc, const float* vsc, float* orow, int lane) {
    unsigned k0 = ((unsigned)__hip_atomic_load(ex + lane, __ATOMIC_RELAXED, __HIP_MEMORY_SCOPE_AGENT) << 7) | (unsigned)lane;
    unsigned k1 = ((unsigned)__hip_atomic_load(ex + 64 + lane, __ATOMIC_RELAXED, __HIP_MEMORY_SCOPE_AGENT) << 7) | (unsigned)(64 + lane);
#define P11_CX(J, ASC0, ASC1) do { const unsigned o0_ = (unsigned)__shfl_xor((int)k0, (J)), o1_ = (unsigned)__shfl_xor((int)k1, (J)); const bool lowl_ = (lane & (J)) == 0; \
        k0 = (lowl_ == (ASC0)) ? (k0 < o0_ ? k0 : o0_) : (k0 > o0_ ? k0 : o0_); k1 = (lowl_ == (ASC1)) ? (k1 < o1_ ? k1 : o1_) : (k1 > o1_ ? k1 : o1_); } while (0)
#pragma unroll
    for (int kk = 2; kk <= 32; kk <<= 1) { const bool asc = (lane & kk) == 0;
#pragma unroll
        for (int j = kk >> 1; j >= 1; j >>= 1) P11_CX(j, asc, asc); }
#pragma unroll
    for (int j = 32; j >= 1; j >>= 1) P11_CX(j, true, false);
    { const unsigned lo_ = k0 < k1 ? k0 : k1, hi_ = k0 < k1 ? k1 : k0; k0 = lo_; k1 = hi_; }
#pragma unroll
    for (int j = 32; j >= 1; j >>= 1) P11_CX(j, true, true);
#undef P11_CX
    const int e_lo = (int)(k0 >> 7), e_hi = (int)(k1 >> 7);
    const float us_lo = usc[e_lo], us_hi = usc[e_hi];
    const float gv_lo = __hip_atomic_load(pg + (k0 & 127u), __ATOMIC_RELAXED, __HIP_MEMORY_SCOPE_AGENT) * vsc[e_lo], gv_hi = __hip_atomic_load(pg + (k1 & 127u), __ATOMIC_RELAXED, __HIP_MEMORY_SCOPE_AGENT) * vsc[e_hi];
    f32x2 h2[32], y[32];
    asm volatile("" : "+s"(nffn));
#pragma unroll
    for (int i = 0; i < 16; ++i) {
        const v2u aw = *(const v2u*)(x1row + i * 256 + lane * 4); const f32x4 g = *(const f32x4*)(nffn + i * 256 + lane * 4);
        h2[2 * i] = (f32x2){bflo(aw.x) * inv2 * g.x, bfhi(aw.x) * inv2 * g.y}; h2[2 * i + 1] = (f32x2){bflo(aw.y) * inv2 * g.z, bfhi(aw.y) * inv2 * g.w};
    }
#pragma unroll
    for (int i = 0; i < 32; ++i) y[i] = (f32x2){0.f, 0.f};
    asm volatile("s_waitcnt vmcnt(0)" ::: "memory");
    const unsigned char* ul = U6 + lane * 16; const unsigned char* vl = V6 + lane * 16;
    {
#pragma unroll
        for (int j = 0; j < 8; ++j) { const int ej = __builtin_amdgcn_readlane(e_lo, j); P11_DMA(ul + (size_t)ej * ROW4, ring + j * ROW4, 2); }
    }
    float cf_lo = 0.f, cf_hi = 0.f;
#define P11_ROW(k, NEXT_BASE, NEXT_REG, NEXT_LANE, W) \
        LAS unsigned char* su = ring + ((k) & 7) * ROW4; \
        const int en = __builtin_amdgcn_readlane(NEXT_REG, NEXT_LANE); \
        asm volatile("s_waitcnt vmcnt(14)" ::: "memory");            \
        v4u W[2]; \
        _Pragma("unroll") for (int i = 0; i < 2; ++i) W[i] = *(const LAS v4u*)(su + i * 1024 + lane * 16); \
        asm volatile("s_waitcnt lgkmcnt(0)" ::: "memory"); \
        P11_DMA((NEXT_BASE) + (size_t)en * ROW4, su, 2);
#define P11_U(k, US_REG, GV_REG, CF_REG, NEXT_BASE, NEXT_REG, NEXT_LANE) do { \
        P11_ROW(k, NEXT_BASE, NEXT_REG, NEXT_LANE, uw) \
        const float usk = readlane_f(US_REG, (k) & 63), gvk = readlane_f(GV_REG, (k) & 63); \
        f32x2 d0 = {0.f, 0.f}, d1 = {0.f, 0.f}, d2 = {0.f, 0.f}, d3 = {0.f, 0.f}; \
        { const unsigned w8[8] = {uw[0].x, uw[0].y, uw[0].z, uw[0].w, uw[1].x, uw[1].y, uw[1].z, uw[1].w}; \
          _Pragma("unroll") for (int w = 0; w < 8; ++w) { \
            d0 = __builtin_amdgcn_cvt_scalef32_pk_f32_fp4(w8[w], 1.0f, 0) * h2[4 * w + 0] + d0; d1 = __builtin_amdgcn_cvt_scalef32_pk_f32_fp4(w8[w], 1.0f, 1) * h2[4 * w + 1] + d1; \
            d2 = __builtin_amdgcn_cvt_scalef32_pk_f32_fp4(w8[w], 1.0f, 2) * h2[4 * w + 2] + d2; d3 = __builtin_amdgcn_cvt_scalef32_pk_f32_fp4(w8[w], 1.0f, 3) * h2[4 * w + 3] + d3; } } \
        const f32x2 ds = (d0 + d1) + (d2 + d3); \
        const float d = wave_sum_dpp(ds.x + ds.y) * usk; \
        const float cf = gelu_exact(d) * gvk; \
        CF_REG = (lane == ((k) & 63)) ? cf : CF_REG; } while (0)
#define P11_V(k, CF_REG, NEXT_BASE, NEXT_REG, NEXT_LANE) do { \
        P11_ROW(k, NEXT_BASE, NEXT_REG, NEXT_LANE, vw) \
        const float cfk = readlane_f(CF_REG, (k) & 63); const f32x2 cf2_ = {cfk, cfk}; \
        const unsigned w8_[8] = {vw[0].x, vw[0].y, vw[0].z, vw[0].w, vw[1].x, vw[1].y, vw[1].z, vw[1].w}; \
        _Pragma("unroll") for (int w_ = 0; w_ < 8; ++w_) { \
            y[4 * w_ + 0] = __builtin_amdgcn_cvt_scalef32_pk_f32_fp4(w8_[w_], 1.0f, 0) * cf2_ + y[4 * w_ + 0]; y[4 * w_ + 1] = __builtin_amdgcn_cvt_scalef32_pk_f32_fp4(w8_[w_], 1.0f, 1) * cf2_ + y[4 * w_ + 1]; \
            y[4 * w_ + 2] = __builtin_amdgcn_cvt_scalef32_pk_f32_fp4(w8_[w_], 1.0f, 2) * cf2_ + y[4 * w_ + 2]; y[4 * w_ + 3] = __builtin_amdgcn_cvt_scalef32_pk_f32_fp4(w8_[w_], 1.0f, 3) * cf2_ + y[4 * w_ + 3]; } } while (0)
#pragma unroll 2
    for (int k = 0; k < 56; ++k) P11_U(k, us_lo, gv_lo, cf_lo, ul, e_lo, k + 8);
#pragma unroll 1
    for (int k = 56; k < 64; ++k) P11_U(k, us_lo, gv_lo, cf_lo, ul, e_hi, k - 56);
#pragma unroll 2
    for (int k = 64; k < 120; ++k) P11_U(k, us_hi, gv_hi, cf_hi, ul, e_hi, k - 56);
#pragma unroll 1
    for (int k = 120; k < 128; ++k) P11_U(k, us_hi, gv_hi, cf_hi, vl, e_lo, k - 120);
#pragma unroll 1
    for (int k = 0; k < 56; ++k) P11_V(k, cf_lo, vl, e_lo, k + 8);
#pragma unroll 1
    for (int k = 56; k < 64; ++k) P11_V(k, cf_lo, vl, e_hi, k - 56);
#pragma unroll 1
    for (int k = 64; k < 120; ++k) P11_V(k, cf_hi, vl, e_hi, k - 56);
#pragma unroll 1
    for (int k = 120; k < 128; ++k) P11_V(k, cf_hi, vl, e_lo, k - 120);
#undef P11_ROW
#undef P11_U
#undef P11_V
    const float ysc = 1.0f;
    asm volatile("s_waitcnt vmcnt(0)" ::: "memory");
#pragma unroll
    for (int i = 0; i < 16; ++i) {
        const v2u aw = *(const v2u*)(x1row + i * 256 + lane * 4);
        *(f32x4*)(orow + i * 256 + lane * 4) = (f32x4){bflo(aw.x) + ysc * y[2 * i].x, bfhi(aw.x) + ysc * y[2 * i].y, bflo(aw.y) + ysc * y[2 * i + 1].x, bfhi(aw.y) + ysc * y[2 * i + 1].y};
    }
}
DI void row_load(const float* xrow, f32x4 (&v)[16], int lane) {
#pragma unroll
    for (int i = 0; i < 16; ++i) v[i] = __builtin_nontemporal_load((const f32x4*)(xrow + i * 256 + lane * 4));
}
DI void row_emit_fp4(const f32x4 (&v)[16], unsigned char* orow, float* sc_out, int lane);
DI void row_to_fp4(const float* xrow, unsigned char* orow, float* sc_out, int lane) { f32x4 v[16]; row_load(xrow, v, lane); row_emit_fp4(v, orow, sc_out, lane); }
DI void row_emit_fp4(const f32x4 (&v)[16], unsigned char* orow, float* sc_out, int lane) {
    float mx = 0.f, ss = 0.f;
#pragma unroll
    for (int i = 0; i < 16; ++i) { const f32x4 a = v[i];
        mx = fmaxf(mx, fmaxf(fmaxf(fabsf(a.x), fabsf(a.y)), fmaxf(fabsf(a.z), fabsf(a.w)))); ss += (a.x * a.x + a.y * a.y) + (a.z * a.z + a.w * a.w); }
#pragma unroll
    for (int o = 1; o < 64; o <<= 1) { mx = fmaxf(mx, __shfl_xor(mx, o)); ss += __shfl_xor(ss, o); }
    const float top = fminf(mx, 3.0f * sqrtf(ss * (1.0f / DM)));
    const float s = top > 0.f ? 6.0f / top : 1.0f;
    if (lane == 0) *sc_out = top > 0.f ? top * (1.0f / 6.0f) : 1.0f;
    unsigned pk[8];
#pragma unroll
    for (int w = 0; w < 8; ++w) {
        unsigned p = 0;
#define SAT6(x) fminf(fmaxf((x), -6.0f), 6.0f)
        p = __builtin_amdgcn_cvt_scalef32_pk_fp4_f32(p, SAT6(v[2 * w].x * s), SAT6(v[2 * w].y * s), 1.0f, 0);
        p = __builtin_amdgcn_cvt_scalef32_pk_fp4_f32(p, SAT6(v[2 * w].z * s), SAT6(v[2 * w].w * s), 1.0f, 1);
        p = __builtin_amdgcn_cvt_scalef32_pk_fp4_f32(p, SAT6(v[2 * w + 1].x * s), SAT6(v[2 * w + 1].y * s), 1.0f, 2);
        p = __builtin_amdgcn_cvt_scalef32_pk_fp4_f32(p, SAT6(v[2 * w + 1].z * s), SAT6(v[2 * w + 1].w * s), 1.0f, 3);
#undef SAT6
        pk[w] = p;
    }
#pragma unroll
    for (int p = 0; p < 2; ++p) *(v4u*)(orow + p * 1024 + lane * 16) = (v4u){pk[4 * p], pk[4 * p + 1], pk[4 * p + 2], pk[4 * p + 3]};
}
DI void xrow_to_fp8(const float* xrow, unsigned char* orow, float* rowf_out, unsigned char* orow4, float* rowf4_out, int lane) {
    f32x4 v[16]; float mx = 0.f, ss = 0.f;
#pragma unroll
    for (int i = 0; i < 4; ++i)
#pragma unroll
        for (int jj = 0; jj < 4; ++jj) { const f32x4 a = *(const f32x4*)(xrow + i * 1024 + lane * 16 + jj * 4); v[i * 4 + jj] = a;
            mx = fmaxf(mx, fmaxf(fmaxf(fabsf(a.x), fabsf(a.y)), fmaxf(fabsf(a.z), fabsf(a.w)))); ss += (a.x * a.x + a.y * a.y) + (a.z * a.z + a.w * a.w); }
#pragma unroll
    for (int o = 1; o < 64; o <<= 1) { mx = fmaxf(mx, __shfl_xor(mx, o)); ss += __shfl_xor(ss, o); }
    const float s = mx > 0.f ? 256.0f / mx : 1.0f;
    const float rms = sqrtf(ss * (1.0f / DM)), inv = 1.0f / sqrtf(ss * (1.0f / DM) + EPS);
    const float top4 = fminf(mx, 3.0f * rms), s4 = top4 > 0.f ? 6.0f / top4 : 1.0f;
    if (lane == 0) { *rowf_out = (mx > 0.f ? mx * (1.0f / 256.0f) : 1.0f) * inv; *rowf4_out = (top4 > 0.f ? top4 * (1.0f / 6.0f) : 1.0f) * inv; }
#pragma unroll
    for (int i = 0; i < 4; ++i) {
        v4u o;
        o.x = pk4_fp8(v[i * 4 + 0].x * s, v[i * 4 + 0].y * s, v[i * 4 + 0].z * s, v[i * 4 + 0].w * s); o.y = pk4_fp8(v[i * 4 + 1].x * s, v[i * 4 + 1].y * s, v[i * 4 + 1].z * s, v[i * 4 + 1].w * s);
        o.z = pk4_fp8(v[i * 4 + 2].x * s, v[i * 4 + 2].y * s, v[i * 4 + 2].z * s, v[i * 4 + 2].w * s); o.w = pk4_fp8(v[i * 4 + 3].x * s, v[i * 4 + 3].y * s, v[i * 4 + 3].z * s, v[i * 4 + 3].w * s);
        *(v4u*)(orow + i * 1024 + lane * 16) = o;
#define SAT6(x) fminf(fmaxf((x), -6.0f), 6.0f)
        v2u q;
        { unsigned p = 0; p = __builtin_amdgcn_cvt_scalef32_pk_fp4_f32(p, SAT6(v[i * 4 + 0].x * s4), SAT6(v[i * 4 + 0].y * s4), 1.0f, 0); p = __builtin_amdgcn_cvt_scalef32_pk_fp4_f32(p, SAT6(v[i * 4 + 0].z * s4), SAT6(v[i * 4 + 0].w * s4), 1.0f, 1);
          p = __builtin_amdgcn_cvt_scalef32_pk_fp4_f32(p, SAT6(v[i * 4 + 1].x * s4), SAT6(v[i * 4 + 1].y * s4), 1.0f, 2); p = __builtin_amdgcn_cvt_scalef32_pk_fp4_f32(p, SAT6(v[i * 4 + 1].z * s4), SAT6(v[i * 4 + 1].w * s4), 1.0f, 3); q.x = p; }
        { unsigned p = 0; p = __builtin_amdgcn_cvt_scalef32_pk_fp4_f32(p, SAT6(v[i * 4 + 2].x * s4), SAT6(v[i * 4 + 2].y * s4), 1.0f, 0); p = __builtin_amdgcn_cvt_scalef32_pk_fp4_f32(p, SAT6(v[i * 4 + 2].z * s4), SAT6(v[i * 4 + 2].w * s4), 1.0f, 1);
          p = __builtin_amdgcn_cvt_scalef32_pk_fp4_f32(p, SAT6(v[i * 4 + 3].x * s4), SAT6(v[i * 4 + 3].y * s4), 1.0f, 2); p = __builtin_amdgcn_cvt_scalef32_pk_fp4_f32(p, SAT6(v[i * 4 + 3].z * s4), SAT6(v[i * 4 + 3].w * s4), 1.0f, 3); q.y = p; }
#undef SAT6
        *(v2u*)(orow4 + i * 512 + lane * 8) = q;
    }
}
#ifndef LATE_ROWS
#define LATE_ROWS 16
#endif
struct Args { const void* in[19]; float* out; unsigned char* ws; int ph_lo, ph_hi; };
DI void conv_rows(LAS unsigned char* lds, int m_lo, int m_hi) {
    const __attribute__((address_space(4))) Args* ka = (const __attribute__((address_space(4))) Args*)__builtin_amdgcn_kernarg_segment_ptr();
    asm volatile("" : "+s"(ka));
    int tid = threadIdx.x; asm volatile("" : "+v"(tid));
    const int lane = tid & 63, wave = __builtin_amdgcn_readfirstlane(tid >> 6);
    const int gw = blockIdx.x * NWAVES + wave, NGW = gridDim.x * NWAVES;
    unsigned char* ws = ka->ws;
    const float* peer_u = (const float*)ka->in[17]; const float* peer_v = (const float*)ka->in[18];
    unsigned char* U8 = ws + WS_U; unsigned char* V8 = ws + WS_V; float* usc = (float*)(ws + WS_USC); float* vsc = (float*)(ws + WS_VSC);
    LAS unsigned char* buf = lds + wave * 16896;
#define CONV_SRC(m) ((const unsigned char*)((m) < NEXP ? peer_u + (size_t)(m) * DM : peer_v + (size_t)((m) - NEXP) * DM) + lane * 16)
    if (m_lo + gw < m_hi) P11_DMA(CONV_SRC(m_lo + gw), buf, 16);
#pragma unroll 1
    for (int m = m_lo + gw; m < m_hi; m += NGW) {
        asm volatile("s_waitcnt vmcnt(0)" ::: "memory");
        f32x4 v[16];
#pragma unroll
        for (int i = 0; i < 16; ++i) v[i] = *(const LAS f32x4*)(buf + i * 1024 + lane * 16);
        asm volatile("s_waitcnt lgkmcnt(0)" ::: "memory");
        const int mn = m + NGW;
        if (mn < m_hi) P11_DMA(CONV_SRC(mn), buf, 16);
        if (m < NEXP) row_emit_fp4(v, U8 + (size_t)m * ROW4, usc + m, lane); else row_emit_fp4(v, V8 + (size_t)(m - NEXP) * ROW4, vsc + (m - NEXP), lane);
    }
    asm volatile("s_waitcnt vmcnt(0)" ::: "memory");
#undef CONV_SRC
}
DI void conv_job(LAS unsigned char* lds) {
    const __attribute__((address_space(4))) Args* ka = (const __attribute__((address_space(4))) Args*)__builtin_amdgcn_kernarg_segment_ptr();
    asm volatile("" : "+s"(ka));
    int tid = threadIdx.x; asm volatile("" : "+v"(tid));
    const int lane = tid & 63, wave = __builtin_amdgcn_readfirstlane(tid >> 6);
    const int G = gridDim.x, gw = blockIdx.x * NWAVES + wave, NGW = G * NWAVES;
    unsigned char* ws = ka->ws;
    const float* w_branch_a = (const float*)ka->in[9]; const float* w_branch_b = (const float*)ka->in[10]; const float* w_out = (const float*)ka->in[13]; const float* norm_ffn = (const float*)ka->in[14];
    const float* w_peer_q = (const float*)ka->in[15]; const float* peer_u = (const float*)ka->in[17]; const float* peer_v = (const float*)ka->in[18];
    const float* swa = (const float*)(ws + WS_SWA); const float* swb = (const float*)(ws + WS_SWB); const float* swo = (const float*)(ws + WS_SWO);
    unsigned char* WCQ = ws + WS_WCQ; unsigned char* WOQ = ws + WS_WOQ; bf16* WQT = (bf16*)(ws + WS_WQT);
    unsigned char* U8 = ws + WS_U; unsigned char* V8 = ws + WS_V; float* usc = (float*)(ws + WS_USC); float* vsc = (float*)(ws + WS_VSC);
            const float q_a = 1.0f / swa[0], q_b = 1.0f / swb[0], q_o = 1.0f / swo[0];
    LAS float* scr = (LAS float*)(lds + wave * 16896);
    constexpr int I_A = (2048 / 128) * (DM / 32), I_B = (512 / 128) * (DM / 32), I_O = (DM / 128) * (DM / 32), I_Q = (DM / 128) * (QW / 32);
    for (int it = gw; it < I_A + I_B + I_O + I_Q; it += NGW) {
        int r = it;
        if (r < I_A) { transpose_tile<1>(w_branch_a, DM, WCQ, YCW, 0, 512, nullptr, q_a, scr, r, lane); continue; } r -= I_A;
        if (r < I_B) { transpose_tile<1>(w_branch_b, DM, WCQ, YCW, 0, 0, nullptr, q_b, scr, r, lane); continue; } r -= I_B;
        if (r < I_O) { transpose_tile<1>(w_out, DM, WOQ, DM, 0, 0, nullptr, q_o, scr, r, lane); continue; } r -= I_O;
        transpose_tile<0>(w_peer_q, QW, (unsigned char*)WQT, DM * 2, 0, 0, norm_ffn, 1.0f, scr, r, lane);
    }
    const int n_light = ((SEQ / 256) * (INW / 256)) % G ? G - ((SEQ / 256) * (INW / 256)) % G : 0, TBL_LATE = n_light * NWAVES * LATE_ROWS;
    conv_rows(lds, NEXP < 2 * NEXP - TBL_LATE ? NEXP : 2 * NEXP - TBL_LATE, 2 * NEXP - TBL_LATE);
}
__global__ void __launch_bounds__(NTHREADS, 2) fwd(Args args) {
    extern __shared__ __attribute__((aligned(16))) unsigned char lds_raw[];
    LAS unsigned char* lds = (LAS unsigned char*)lds_raw;
    volatile LAS unsigned* MISC = (volatile LAS unsigned*)(lds + MISC_OFF);
    const int tid = threadIdx.x, lane = tid & 63, wave = __builtin_amdgcn_readfirstlane(tid >> 6);
    const int G = gridDim.x, bid = blockIdx.x;
    const int gw = bid * NWAVES + wave, NGW = G * NWAVES;
    unsigned char* ws = args.ws;
    const float* x = (const float*)args.in[0]; const int* positions = (const int*)args.in[1]; const float* norm_mix = (const float*)args.in[2];
    const float* w_in = (const float*)args.in[3]; const float* q_norm_a = (const float*)args.in[4]; const float* k_norm_a = (const float*)args.in[5];
    const float* sinks_a = (const float*)args.in[6]; const float* q_norm_b = (const float*)args.in[7]; const float* k_norm_b = (const float*)args.in[8];
    const float* w_branch_a = (const float*)args.in[9]; const float* w_branch_b = (const float*)args.in[10]; const float* w_gate = (const float*)args.in[11];
    const float* b_gate = (const float*)args.in[12]; const float* w_out = (const float*)args.in[13]; const float* norm_ffn = (const float*)args.in[14];
    const float* w_peer_q = (const float*)args.in[15]; const float* sub_keys = (const float*)args.in[16]; const float* peer_u = (const float*)args.in[17];
    const float* peer_v = (const float*)args.in[18];
    float* out = args.out;
    float* rowf1 = (float*)(ws + WS_ROWF1); float* inv2 = (float*)(ws + WS_INV2); float* lse = (float*)(ws + WS_LSE);
    bf16* skb = (bf16*)(ws + WS_SK); float* ropec = (float*)(ws + WS_ROPE); float* ropes = (float*)(ws + WS_ROPE + 512 * 1024);
    int* experts = (int*)(ws + WS_PE); float* pgates = (float*)(ws + WS_PG);
    float* sw1 = (float*)(ws + WS_SW1); float* swa = (float*)(ws + WS_SWA); float* swb = (float*)(ws + WS_SWB); float* swo = (float*)(ws + WS_SWO);
    unsigned char* W1Q = ws + WS_W1Q; unsigned char* WCQ = ws + WS_WCQ; unsigned char* WOQ = ws + WS_WOQ; bf16* WQT = (bf16*)(ws + WS_WQT);
    unsigned char* XQ4 = ws + WS_XQ4; unsigned char* WG4 = ws + WS_WG4; float* rowf4 = (float*)(ws + WS_ROWF4);
    unsigned char* XQ = ws + WS_XQ; bf16* XB = (bf16*)(ws + WS_XB); bf16* PROJ = (bf16*)(ws + WS_PROJ); unsigned char* MERGED = ws + WS_MERGED;
    unsigned char* GATES = ws + WS_GATES; bf16* QB = (bf16*)(ws + WS_Q); unsigned char* YCAT = ws + WS_YCAT; bf16* OG = (bf16*)(ws + WS_OG);
    float* rowpart = (float*)(ws + WS_ROWPART);
    unsigned char* U8 = ws + WS_U; unsigned char* V8 = ws + WS_V; float* usc = (float*)(ws + WS_USC); float* vsc = (float*)(ws + WS_VSC);

    if (tid < 64) MISC[tid] = 0u;
    __syncthreads();
    XcdBarrier bar = xcd_barrier_post((unsigned*)(ws + WS_CTL) + CW_BAR, MISC + 8);
    const int lo = args.ph_lo, hi = args.ph_hi;
#ifndef ONLY_PHASE
#define ONLY_PHASE -1
#endif
#define IN(k) ((ONLY_PHASE < 0 || ONLY_PHASE == (k)) && lo <= (k) && (k) < hi)
#ifndef REP_PHASE
#define REP_PHASE -1
#endif
#define REPS(k) ((REP_PHASE == (k)) ? 2 : 1)
#define SEAM(k) do { if ((k) + 1 < hi || REPS(k) > 1) xcd_barrier(bar); } while (0)

    if (IN(0)) for (int rep_ = 0; rep_ < REPS(0); ++rep_) {
#ifndef P0X
#define P0X 1
#define P0W 1
#define P0T 1
#endif
        for (int rx = 0; rx < P0X; ++rx)
        for (int m = gw; m < SEQ; m += NGW) xrow_to_fp8(x + (size_t)m * DM, XQ + (size_t)m * DM, rowf1 + m, XQ4 + (size_t)m * (DM / 2), rowf4 + m, lane);
        {
            LAS float* red = (LAS float*)(lds + 8 * 16896);
            float rms_g, m_in, m_g0, m_a, m_b, m_o; wg_sample_all(w_in, w_gate, w_branch_a, w_branch_b, w_out, norm_mix, red, m_in, m_g0, rms_g, m_a, m_b, m_o);
            const float m_g = fminf(m_g0, 3.0f * rms_g) * (128.0f / 6.0f);
            const float q_in = m_in > 0.f ? 128.0f / m_in : 1.0f, q_g = m_g > 0.f ? 128.0f / m_g : 1.0f, q_a = m_a > 0.f ? 128.0f / m_a : 1.0f, q_b = m_b > 0.f ? 128.0f / m_b : 1.0f, q_o = m_o > 0.f ? 128.0f / m_o : 1.0f;
            for (int n = bid * NTHREADS + tid; n < N1 + 3 * DM; n += G * NTHREADS) {
                if (n < INW) sw1[n] = 1.0f / q_in; else if (n < N1) sw1[n] = 1.0f / q_g;
                else if (n < N1 + DM) swa[n - N1] = 1.0f / q_a; else if (n < N1 + 2 * DM) swb[n - N1 - DM] = 1.0f / q_b; else swo[n - N1 - 2 * DM] = 1.0f / q_o;
            }
            LAS float* scr = (LAS float*)(lds + wave * 16896);
            constexpr int I_IN = (DM / 128) * (INW / 32), I_G = (DM / 128) * (GATEW / 32), I_A = (2048 / 128) * (DM / 32), I_B = (512 / 128) * (DM / 32), I_O = (DM / 128) * (DM / 32), I_Q = (DM / 128) * (QW / 32);
            constexpr int NIT = I_IN + I_G + I_A + I_B + I_O + I_Q;
            (void)NIT; (void)q_a; (void)q_b; (void)q_o;
            for (int rw = 0; rw < P0W; ++rw)
            for (int it = gw; it < I_IN + I_G; it += NGW) {
                int r = it;
                if (r < I_IN) { transpose_tile<1>(w_in, INW, W1Q, DM, 0, 0, norm_mix, q_in, scr, r, lane); continue; } r -= I_IN;
                transpose_tile<2>(w_gate, GATEW, WG4, DM / 2, 0, 0, norm_mix, q_g, scr, r, lane);
            }
        }
        const int n_light = ((SEQ / 256) * (INW / 256)) % G ? G - ((SEQ / 256) * (INW / 256)) % G : 0, TBL_LATE = n_light * NWAVES * LATE_ROWS;
        (void)TBL_LATE;
        for (int i = bid * NTHREADS + tid; i < 16 * 128 * 128 / 2; i += G * NTHREADS) { const f32x2 v = *(const f32x2*)(sub_keys + 2 * (size_t)i); ((unsigned*)skb)[i] = pk2(v.x, v.y); }
        if (bid == 0) { float* gtab = (float*)(ws + WS_GTAB); gtab[tid] = tid < 128 ? q_norm_a[tid] : (tid < 256 ? k_norm_a[tid - 128] : (tid < 384 ? q_norm_b[tid - 256] : k_norm_b[tid - 384])); }
        for (int i = bid * NTHREADS + tid; i < SEQ * 16; i += G * NTHREADS) {
            const int t = i >> 4, f = i & 15;
            const float invf = expf(-13.122363377404328f * (float)f / 16.0f);
            const float ang = (float)positions[t] * invf;
            const double rev = (double)ang * 0.15915494309189535; const float fr = (float)(rev - rint(rev));
            ropec[i] = __builtin_amdgcn_cosf(fr); ropes[i] = __builtin_amdgcn_sinf(fr);
        }
        SEAM(0);
    }
    if (IN(1)) for (int rep_ = 0; rep_ < REPS(1); ++rep_) {
        {
            pg8::Gemm g{(const bf16*)XQ, (const bf16*)W1Q, SEQ, INW, DM / 2, DM / 2, DM / 2}; pg8::StaticOrder S; S.init(SEQ, INW, G, bid);
            EpiP1 E{ws, (LAS float*)(lds + 131072 + 1024)};
            pg8::gemm_phase<EpiP1, pg8::StaticOrder, true, true, 1>(lds, g, S, E);
        }
        {
            pg8::Gemm g{(const bf16*)XQ4, (const bf16*)WG4, SEQ, GATEW, DM / 4, DM / 4, DM / 4}; pg8::StaticOrder S; S.init(SEQ, GATEW, G, bid);
            EpiG4 E{ws, b_gate};
            pg8::gemm_phase<EpiG4, pg8::StaticOrder, true, true, 2>(lds, g, S, E);
        }
        {
            const int n_heavy = ((SEQ / 256) * (INW / 256)) % G, n_light = n_heavy ? G - n_heavy : 0, TBL_LATE = n_light * NWAVES * LATE_ROWS;
            if (n_light && bid >= n_heavy) {
                const int lw = (bid - n_heavy) * NWAVES + wave;
#pragma unroll 1
                for (int j = 0; j < LATE_ROWS; ++j) { const int m = 2 * NEXP - TBL_LATE + j * (n_light * NWAVES) + lw;
                    if (m < NEXP) row_to_fp4(peer_u + (size_t)m * DM, U8 + (size_t)m * ROW4, usc + m, lane);
                    else row_to_fp4(peer_v + (size_t)(m - NEXP) * DM, V8 + (size_t)(m - NEXP) * ROW4, vsc + (m - NEXP), lane); }
            }
        }
        SEAM(1);
    }
    if (IN(2)) for (int rep_ = 0; rep_ < REPS(2); ++rep_) {
        const bool conv_first = ((bid >> 3) & 1) == 0;
        if (conv_first) { conv_job(lds); __syncthreads(); }
        attention_phase(lds, PROJ, sinks_a, YCAT, OG, lse, bid, G);
        if (!conv_first) { __syncthreads(); conv_job(lds); }
        SEAM(2);
    }
    if (IN(3)) for (int rep_ = 0; rep_ < REPS(3); ++rep_) { combine_phase(OG, lse, YCAT, bid * NTHREADS + tid, G * NTHREADS); SEAM(3); }
    if (IN(4)) for (int rep_ = 0; rep_ < REPS(4); ++rep_) {
        pg8::Gemm g{(const bf16*)YCAT, (const bf16*)WCQ, SEQ, DM, YCW / 2, YCW / 2, YCW / 2}; pg8::StaticOrder S; S.init(SEQ, DM, G, bid);
        EpiMerge E{GATES, MERGED, swa, swb};
        pg8::gemm_phase<EpiMerge, pg8::StaticOrder, true, true, true>(lds, g, S, E);
        SEAM(4);
    }
    if (IN(5)) for (int rep_ = 0; rep_ < REPS(5); ++rep_) {
        const bool rows_first = ((bid >> 3) & 1) != 0;
        if (rows_first) { conv_rows(lds, 0, NEXP); __syncthreads(); }
        pg8::Gemm g{(const bf16*)MERGED, (const bf16*)WOQ, SEQ, DM, DM / 2, DM / 2, DM / 2}; pg8::StaticOrder S; S.init(SEQ, DM, G, bid);
        EpiOut E{x, out, swo, XB, rowpart};
        pg8::gemm_phase<EpiOut, pg8::StaticOrder, true, true, true>(lds, g, S, E);
        if (!rows_first) { __syncthreads(); conv_rows(lds, 0, NEXP); }
        SEAM(5);
    }
    if (IN(6)) for (int rep_ = 0; rep_ < REPS(6); ++rep_) {
        pg8::Gemm g{XB, WQT, SEQ, QW, DM, DM, DM}; pg8::StaticOrder S; S.init(SEQ, QW, G, bid);
        LAS float* inv2l = (LAS float*)(lds + 131072);
        pg8::Unit u0;
        if (S.next(0, u0)) {
            const int rl = tid >> 1, hf = tid & 1; const float* rp = rowpart + (size_t)(u0.pm * 256 + rl) * 64 + hf * 32;
            float s = 0.f;
#pragma unroll
            for (int j = 0; j < 8; ++j) { const f32x4 v = *(const f32x4*)(rp + 4 * j); s += (v.x + v.y) + (v.z + v.w); }
            s += __shfl_xor(s, 1);
            const float iv = 1.0f / sqrtf(s * (1.0f / DM) + EPS);
            if (hf == 0) { inv2l[rl] = iv; if (u0.pn == 0) inv2[u0.pm * 256 + rl] = iv; }
        }
        __syncthreads();
        EpiQ E{QB, inv2l};
        pg8::gemm_phase<EpiQ, pg8::StaticOrder, true, true, false>(lds, g, S, E);
        SEAM(6);
    }
    if (IN(7)) for (int rep_ = 0; rep_ < REPS(7); ++rep_) {
        for (int tb = bid; tb < SEQ / 32; tb += G) {
            routing_block(lds, QB, skb, experts, pgates, tb);
            asm volatile("s_waitcnt vmcnt(0)" ::: "memory");
            __syncthreads();
#pragma unroll 1
            for (int j = 0; j < 4; ++j) { const int t = tb * 32 + wave * 4 + j;
                peer_token(lds + wave * (4 * RSLOT), XB + (size_t)t * DM, inv2[t], norm_ffn, experts + (size_t)t * 128, pgates + (size_t)t * 128, U8, V8, usc, vsc, out + (size_t)t * DM, lane); }
            __syncthreads();
        }
    }
#undef IN
#undef SEAM
}

extern "C" void kernel_launch(void* const* d_in, const int* in_sizes, int n_in, void* d_out, int out_size, void* d_ws, size_t ws_size, hipStream_t stream) {
    static int grid = 0;
    if (grid == 0) {
        if (n_in != 19 || out_size != SEQ * DM || ws_size < WS_END) { fprintf(stderr, "kernel_launch: unexpected shapes (n_in %d, out %d, ws %zu); nothing launched\n", n_in, out_size, ws_size); grid = -1; return; }
        int dev = 0, cus = 0, per_cu = 0;
        if (hipGetDevice(&dev) != hipSuccess || hipDeviceGetAttribute(&cus, hipDeviceAttributeMultiprocessorCount, dev) != hipSuccess) { grid = -1; return; }
        if (hipFuncSetAttribute((const void*)fwd, hipFuncAttributeMaxDynamicSharedMemorySize, LDS_BYTES) != hipSuccess) { fprintf(stderr, "kernel_launch: hipFuncSetAttribute failed\n"); grid = -1; return; }
        if (hipOccupancyMaxActiveBlocksPerMultiprocessor(&per_cu, (const void*)fwd, NTHREADS, LDS_BYTES) != hipSuccess || per_cu < 1) { fprintf(stderr, "kernel_launch: occupancy query says %d\n", per_cu); (void)hipGetLastError(); grid = -1; return; }
        grid = cus;
    }
    if (grid < 0) return;
    (void)hipMemsetAsync((char*)d_ws + WS_CTL, 0, CTL_ZERO_BYTES, stream);
    Args a{};
    for (int i = 0; i < 19; ++i) a.in[i] = d_in[i];
    a.out = (float*)d_out; a.ws = (unsigned char*)d_ws;
#if MK_N_LAUNCHES == 1
    a.ph_lo = 0; a.ph_hi = NPHASES;
    hipLaunchKernelGGL(fwd, dim3(grid), dim3(NTHREADS), LDS_BYTES, stream, a);
#else
#ifndef TWICE_PHASE
#define TWICE_PHASE -1
#endif
    for (int p = 0; p < NPHASES; ++p) { a.ph_lo = p; a.ph_hi = p + 1; hipLaunchKernelGGL(fwd, dim3(grid), dim3(NTHREADS), LDS_BYTES, stream, a);
        if (p == TWICE_PHASE) hipLaunchKernelGGL(fwd, dim3(grid), dim3(NTHREADS), LDS_BYTES, stream, a);
        if (TWICE_PHASE == 99 && p == NPHASES - 1) { for (int p2 = 0; p2 < NPHASES; ++p2) { a.ph_lo = p2; a.ph_hi = p2 + 1; hipLaunchKernelGGL(fwd, dim3(grid), dim3(NTHREADS), LDS_BYTES, stream, a); } }
        if (TWICE_PHASE == 23 && p == 3) { a.ph_lo = 2; a.ph_hi = 3; hipLaunchKernelGGL(fwd, dim3(grid), dim3(NTHREADS), LDS_BYTES, stream, a); a.ph_lo = 3; a.ph_hi = 4; hipLaunchKernelGGL(fwd, dim3(grid), dim3(NTHREADS), LDS_BYTES, stream, a); } }
#endif
}
```
